# Optimizing an MI355X kernel written in HIP

```python
import math
import jax, jax.numpy as jnp
from jax import lax
import numpy as np

D_MODEL = 1024
BATCH = 16
SEQ = 2048
DEPTH = 1
DEC_BATCH = 32
DEC_SEQ = 32
PAST_LEN = 1024

CHUNK = 64
SSM_WIDTH = 512
SSM_GROUP = 16
SSM_GROUPS = SSM_WIDTH // SSM_GROUP
SSM_STATE = 64
DT_MIN = 1e-3
DT_MAX = 1e-1
MLA_HEADS = 8
NOPE_DIM = 64
ROPE_DIM = 32
V_DIM = 64
MLA_WIDTH = MLA_HEADS * V_DIM
Q_LORA = 256
KV_LORA = 128
MIX_WIDTH = SSM_WIDTH + MLA_WIDTH
IN_WIDTH = 2 * SSM_WIDTH + Q_LORA + KV_LORA + ROPE_DIM + MLA_WIDTH
ROPE_THETA = 10000.0
Q_BLOCK = 128
EPS = 1e-6

kernel_name = 'hymba_s5_mla_streaming_step'


def rmsnorm(x, g):
    xf = x.astype(jnp.float32)
    y = xf * lax.rsqrt(jnp.mean(xf * xf, axis=-1, keepdims=True) + EPS)
    return (y * g.astype(jnp.float32)).astype(x.dtype)


def rope(x, pos):
    half = ROPE_DIM // 2
    inv = ROPE_THETA ** (-jnp.arange(half, dtype=jnp.float32) / half)
    ang = pos.astype(jnp.float32)[:, None] * inv[None, :]
    ang = ang.reshape(ang.shape[0], *([1] * (x.ndim - 3)), half)
    cos, sin = jnp.cos(ang), jnp.sin(ang)
    xf = x.astype(jnp.float32)
    x1, x2 = xf[..., :half], xf[..., half:]
    return jnp.concatenate([x1 * cos - x2 * sin, x1 * sin + x2 * cos], axis=-1).astype(x.dtype)


def _ssm_combine(left, right):
    a_l, b_l = left
    a_r, b_r = right
    return a_r * a_l, a_r * b_l + b_r


def s5_branch(u, h0, p):
    b, s, _ = u.shape
    lam = lax.complex(p['ssm_a_re'].astype(jnp.float32), p['ssm_a_im'].astype(jnp.float32))
    dt = jnp.exp(p['ssm_log_dt'].astype(jnp.float32))[:, None]
    a_bar = jnp.exp(lam * dt)
    b_mat = lax.complex(p['ssm_b_re'].astype(jnp.float32), p['ssm_b_im'].astype(jnp.float32))
    b_bar = ((a_bar - 1.0) / lam)[..., None] * b_mat
    c_mat = lax.complex(p['ssm_c_re'].astype(jnp.float32), p['ssm_c_im'].astype(jnp.float32))
    ug = u.astype(jnp.float32).reshape(b, s, SSM_GROUPS, SSM_GROUP)
    bu = jnp.einsum('gpc,bsgc->bsgp', b_bar, ug.astype(jnp.complex64))
    if h0 is not None:
        bu = bu.at[:, 0].add(a_bar * h0)
    a_seq = jnp.broadcast_to(a_bar, bu.shape)
    _, states = lax.associative_scan(_ssm_combine, (a_seq, bu), axis=1)
    y = jnp.einsum('gcp,bsgp->bsgc', c_mat, states).real
    y = y + p['ssm_d'].astype(jnp.float32).reshape(SSM_GROUPS, SSM_GROUP) * ug
    y = y.reshape(b, s, SSM_WIDTH)
    yg = jax.nn.gelu(y)
    out = yg * jax.nn.sigmoid(yg @ p['w_glu'].astype(jnp.float32) + p['b_glu'].astype(jnp.float32))
    return out.astype(u.dtype), states[:, -1]


def mla_expand(ckv, w_ukv, k_nope_norm):
    b, t, _ = ckv.shape
    kv = (ckv @ w_ukv).reshape(b, t, MLA_HEADS, NOPE_DIM + V_DIM)
    return rmsnorm(kv[..., :NOPE_DIM], k_nope_norm), kv[..., NOPE_DIM:]


def mla_attend(q_nope, q_rope, k_nope, k_rope, v, mask):
    s = jnp.einsum('bqhn,bkhn->bhqk', q_nope, k_nope) + jnp.einsum('bqhr,bkr->bhqk', q_rope, k_rope)
    s = s.astype(jnp.float32) * (NOPE_DIM + ROPE_DIM) ** -0.5
    if mask is not None:
        s = jnp.where(mask, s, -jnp.inf)
    pr = jax.nn.softmax(s, axis=-1)
    return jnp.einsum('bhqk,bkhv->bqhv', pr.astype(v.dtype), v)


def prompt_attention(q_nope, q_rope, k_nope, k_rope, v):
    b, s = q_nope.shape[:2]
    nb = s // Q_BLOCK

    def blockify(t):
        return jnp.moveaxis(t.reshape(b, nb, Q_BLOCK, *t.shape[2:]), 1, 0)

    k_chunk = jnp.arange(s) // CHUNK
    q_chunk = (jnp.arange(s) // CHUNK).reshape(nb, Q_BLOCK)

    def one_block(args):
        qn, qr, qc = args
        mask = qc[:, None] >= k_chunk[None, :]
        return mla_attend(qn, qr, k_nope, k_rope, v, mask)

    o = lax.map(one_block, (blockify(q_nope), blockify(q_rope), q_chunk))
    return jnp.moveaxis(o, 0, 1).reshape(b, s, MLA_WIDTH)


def mixer_layer(x, pos, h0, past_ckv, past_krope, p):
    b, s, _ = x.shape
    h = rmsnorm(x, p['norm_in'])
    z = h @ p['w_in']
    cuts = np.cumsum([SSM_WIDTH, SSM_WIDTH, Q_LORA, KV_LORA, ROPE_DIM]).tolist()
    u, g_ssm, c_q, c_kv, k_rope_raw, g_mla = jnp.split(z, cuts, axis=-1)
    y_ssm, h_last = s5_branch(u, h0, p)
    q = (rmsnorm(c_q, p['q_lora_norm']) @ p['w_uq']).reshape(b, s, MLA_HEADS, NOPE_DIM + ROPE_DIM)
    q_nope = rmsnorm(q[..., :NOPE_DIM], p['q_nope_norm'])
    q_rope = rope(rmsnorm(q[..., NOPE_DIM:], p['q_rope_norm']), pos)
    ckv = rmsnorm(c_kv, p['kv_lora_norm'])
    krope = rope(rmsnorm(k_rope_raw, p['k_rope_norm']), pos)
    if past_ckv is None:
        k_nope, v = mla_expand(ckv, p['w_ukv'], p['k_nope_norm'])
        attn = prompt_attention(q_nope, q_rope, k_nope, krope, v)
    else:
        ckv_all = jnp.concatenate([past_ckv, ckv], axis=1)
        krope_all = jnp.concatenate([past_krope, krope], axis=1)
        k_nope, v = mla_expand(ckv_all, p['w_ukv'], p['k_nope_norm'])
        attn = mla_attend(q_nope, q_rope, k_nope, krope_all, v, None).reshape(b, s, MLA_WIDTH)
    mix = jnp.concatenate([rmsnorm(y_ssm, p['out_norm_ssm']) * jax.nn.silu(g_ssm),
                           rmsnorm(attn, p['out_norm_mla']) * jax.nn.silu(g_mla)], axis=-1)
    return x + mix @ p['w_out'], ckv, krope, h_last


def setup_inputs(seed: int = 0) -> dict:
    key = jax.random.key(seed)
    ks = jax.random.split(key, 32)
    f32 = jnp.float32

    def nrm(k, shape, scale):
        return jax.random.normal(k, shape, f32) * scale

    def gain(k, shape):
        return 1.0 + 0.05 * jax.random.normal(k, shape, f32)

    n = jnp.arange(SSM_STATE, dtype=f32)
    return {
        'x_prompt': nrm(ks[0], (BATCH, SEQ, D_MODEL), 1.0),
        'x_sample': nrm(ks[1], (DEC_BATCH, DEC_SEQ, D_MODEL), 1.0),
        'cache_ckv': nrm(ks[2], (DEPTH, DEC_BATCH, PAST_LEN, KV_LORA), 1.0),
        'cache_krope': nrm(ks[3], (DEPTH, DEC_BATCH, PAST_LEN, ROPE_DIM), 1.0),
        'state_ssm_re': nrm(ks[4], (DEPTH, DEC_BATCH, SSM_GROUPS, SSM_STATE), 0.1),
        'state_ssm_im': nrm(ks[5], (DEPTH, DEC_BATCH, SSM_GROUPS, SSM_STATE), 0.1),
        'norm_in': gain(ks[6], (DEPTH, D_MODEL)),
        'w_in': nrm(ks[7], (DEPTH, D_MODEL, IN_WIDTH), D_MODEL ** -0.5),
        'ssm_a_re': -0.5 + nrm(ks[8], (DEPTH, SSM_GROUPS, SSM_STATE), 0.01),
        'ssm_a_im': jnp.pi * n + nrm(ks[9], (DEPTH, SSM_GROUPS, SSM_STATE), 0.01),
        'ssm_log_dt': jax.random.uniform(ks[10], (DEPTH, SSM_GROUPS), f32, math.log(DT_MIN), math.log(DT_MAX)),
        'ssm_b_re': nrm(ks[11], (DEPTH, SSM_GROUPS, SSM_STATE, SSM_GROUP), (2 * SSM_GROUP) ** -0.5),
        'ssm_b_im': nrm(ks[12], (DEPTH, SSM_GROUPS, SSM_STATE, SSM_GROUP), (2 * SSM_GROUP) ** -0.5),
        'ssm_c_re': nrm(ks[13], (DEPTH, SSM_GROUPS, SSM_GROUP, SSM_STATE), (2 * SSM_STATE) ** -0.5),
        'ssm_c_im': nrm(ks[14], (DEPTH, SSM_GROUPS, SSM_GROUP, SSM_STATE), (2 * SSM_STATE) ** -0.5),
        'ssm_d': nrm(ks[15], (DEPTH, SSM_WIDTH), 1.0),
        'w_glu': nrm(ks[16], (DEPTH, SSM_WIDTH, SSM_WIDTH), SSM_WIDTH ** -0.5),
        'b_glu': nrm(ks[17], (DEPTH, SSM_WIDTH), 0.01),
        'q_lora_norm': gain(ks[18], (DEPTH, Q_LORA)),
        'kv_lora_norm': gain(ks[19], (DEPTH, KV_LORA)),
        'w_uq': nrm(ks[20], (DEPTH, Q_LORA, MLA_HEADS * (NOPE_DIM + ROPE_DIM)), Q_LORA ** -0.5),
        'w_ukv': nrm(ks[21], (DEPTH, KV_LORA, MLA_HEADS * (NOPE_DIM + V_DIM)), KV_LORA ** -0.5),
        'q_nope_norm': gain(ks[22], (DEPTH, NOPE_DIM)),
        'k_nope_norm': gain(ks[23], (DEPTH, NOPE_DIM)),
        'q_rope_norm': gain(ks[24], (DEPTH, ROPE_DIM)),
        'k_rope_norm': gain(ks[25], (DEPTH, ROPE_DIM)),
        'out_norm_ssm': gain(ks[26], (DEPTH, SSM_WIDTH)),
        'out_norm_mla': gain(ks[27], (DEPTH, MLA_WIDTH)),
        'w_out': nrm(ks[28], (DEPTH, MIX_WIDTH, D_MODEL), MIX_WIDTH ** -0.5),
    }


def reference(x_prompt, x_sample, cache_ckv, cache_krope, state_ssm_re, state_ssm_im,
              norm_in, w_in, ssm_a_re, ssm_a_im, ssm_log_dt, ssm_b_re, ssm_b_im, ssm_c_re, ssm_c_im,
              ssm_d, w_glu, b_glu, q_lora_norm, kv_lora_norm, w_uq, w_ukv,
              q_nope_norm, k_nope_norm, q_rope_norm, k_rope_norm, out_norm_ssm, out_norm_mla, w_out):
    pos_p = jnp.arange(x_prompt.shape[1])
    pos_s = PAST_LEN + jnp.arange(x_sample.shape[1])
    yp, ys = x_prompt, x_sample
    ckv_p, kr_p, re_p, im_p = [], [], [], []
    ckv_s, kr_s, re_s, im_s = [], [], [], []
    for layer in range(DEPTH):
        p = dict(norm_in=norm_in[layer], w_in=w_in[layer], ssm_a_re=ssm_a_re[layer], ssm_a_im=ssm_a_im[layer],
                 ssm_log_dt=ssm_log_dt[layer], ssm_b_re=ssm_b_re[layer], ssm_b_im=ssm_b_im[layer],
                 ssm_c_re=ssm_c_re[layer], ssm_c_im=ssm_c_im[layer], ssm_d=ssm_d[layer], w_glu=w_glu[layer],
                 b_glu=b_glu[layer], q_lora_norm=q_lora_norm[layer], kv_lora_norm=kv_lora_norm[layer],
                 w_uq=w_uq[layer], w_ukv=w_ukv[layer], q_nope_norm=q_nope_norm[layer],
                 k_nope_norm=k_nope_norm[layer], q_rope_norm=q_rope_norm[layer], k_rope_norm=k_rope_norm[layer],
                 out_norm_ssm=out_norm_ssm[layer], out_norm_mla=out_norm_mla[layer], w_out=w_out[layer])
        yp, ckv1, kr1, h1 = mixer_layer(yp, pos_p, None, None, None, p)
        ckv_p.append(ckv1)
        kr_p.append(kr1)
        re_p.append(jnp.real(h1).astype(yp.dtype))
        im_p.append(jnp.imag(h1).astype(yp.dtype))
        h0 = lax.complex(state_ssm_re[layer].astype(jnp.float32), state_ssm_im[layer].astype(jnp.float32))
        ys, ckv2, kr2, h2 = mixer_layer(ys, pos_s, h0, cache_ckv[layer], cache_krope[layer], p)
        ckv_s.append(ckv2)
        kr_s.append(kr2)
        re_s.append(jnp.real(h2).astype(ys.dtype))
        im_s.append(jnp.imag(h2).astype(ys.dtype))
    return (yp, ys,
            jnp.stack(ckv_p), jnp.stack(kr_p), jnp.stack(re_p), jnp.stack(im_p),
            jnp.stack(ckv_s), jnp.stack(kr_s), jnp.stack(re_s), jnp.stack(im_s))
```

```cpp
#include <hip/hip_runtime.h>
#include <hip/hip_cooperative_groups.h>
#include <cstdio>
namespace cg = cooperative_groups;

typedef unsigned short bfu;
typedef __attribute__((ext_vector_type(8))) short bf16x8;
typedef __attribute__((ext_vector_type(4))) float f32x4;
typedef __attribute__((ext_vector_type(16))) float f32x16;

#define NP 32768
#define NS 1024
#define NTOK 33792
#define NKV 66560
#define EPS 1e-6f

#define O_YP 0L
#define O_YS 33554432L
#define O_CKVP 34603008L
#define O_KRP 38797312L
#define O_REP 39845888L
#define O_IMP 39878656L
#define O_CKVS 39911424L
#define O_KRS 40042496L
#define O_RES 40075264L
#define O_IMS 40140800L

constexpr size_t al256(size_t x) { return (x + 255) & ~(size_t)255; }
constexpr size_t OFF_A2 = 0;
constexpr size_t OFF_YG = OFF_A2 + (size_t)NTOK * 512 * 2;
constexpr size_t OFF_XB = OFF_A2;
constexpr size_t OFF_A1 = al256(OFF_YG + (size_t)NTOK * 512 * 2);
constexpr size_t OFF_WIN = al256(OFF_A1 + (size_t)NTOK * 512 * 2);
constexpr size_t OFF_WUQ = al256(OFF_WIN + (size_t)2048 * 1024 * 2);
constexpr size_t OFF_WUKV = al256(OFF_WUQ + (size_t)768 * 256 * 2);
constexpr size_t OFF_WGLU = al256(OFF_WUKV + (size_t)1024 * 128 * 2);
constexpr size_t OFF_WOUT = al256(OFF_WGLU + (size_t)512 * 512 * 2);
constexpr size_t OFF_KTAB = al256(OFF_WOUT + (size_t)1024 * 1024 * 2);
constexpr size_t OFF_MT = al256(OFF_KTAB + (size_t)32 * 33 * 256 * 2);
constexpr size_t OFF_ET = al256(OFF_MT + (size_t)32 * 128 * 512 * 2);
constexpr size_t OFF_A32 = al256(OFF_ET + (size_t)32 * 512 * 128 * 2);
constexpr size_t OFF_UG = al256(OFF_A32 + (size_t)32 * 64 * 2 * 4);
constexpr size_t OFF_GS = al256(OFF_UG + (size_t)(32 * 1056 + 64) * 512 * 2);
constexpr size_t OFF_GM = al256(OFF_GS + (size_t)NTOK * 512 * 2);
constexpr size_t OFF_CQ = al256(OFF_GM + (size_t)NTOK * 512 * 2);
constexpr size_t OFF_SSQQ = al256(OFF_CQ + (size_t)NTOK * 256 * 2);
constexpr size_t OFF_CKVB = al256(OFF_SSQQ + (size_t)NTOK * 2 * 4);
constexpr size_t OFF_KRB = al256(OFF_CKVB + (size_t)NKV * 128 * 2);
constexpr size_t OFF_QB = al256(OFF_KRB + (size_t)NKV * 32 * 2);
constexpr size_t OFF_KFP = al256(OFF_QB + (size_t)NTOK * 768 * 2);
constexpr size_t OFF_KFS = al256(OFF_KFP + (size_t)16 * 8 * 2048 * 96 * 2);
constexpr size_t OFF_VTP = al256(OFF_KFS + (size_t)32 * 8 * 1056 * 96 * 2);
constexpr size_t OFF_VTS = al256(OFF_VTP + (size_t)16 * 8 * 64 * 2048 * 2);
constexpr size_t OFF_SSQ1 = al256(OFF_VTS + (size_t)32 * 8 * 64 * 1056 * 2);
constexpr size_t OFF_SSQ2 = al256(OFF_SSQ1 + (size_t)NTOK * 4 * 4);
constexpr size_t OFF_RSTD = al256(OFF_SSQ2 + (size_t)NTOK * 8 * 4);
constexpr size_t OFF_BAR = al256(OFF_RSTD + (size_t)NTOK * 4);
constexpr size_t BAR_BYTES = 64 * 256;
constexpr size_t WS_END = al256(OFF_BAR + BAR_BYTES);

constexpr int LDS_BYTES = 74752 + 16;
constexpr int TSTR = 72;
constexpr int TILE_E = 128 * TSTR;
constexpr int CSTR = 129;

struct Params {
  const float* in[29];
  float* out;
  unsigned char* ws;
};

typedef __attribute__((ext_vector_type(2))) float f32x2;
typedef __attribute__((ext_vector_type(2))) __bf16 bf16x2_t;
__device__ __forceinline__ unsigned pack2bf(float a, float b) {
  f32x2 v = {a, b};
  bf16x2_t r = __builtin_convertvector(v, bf16x2_t);
  return *(unsigned*)&r;
}
__device__ __forceinline__ bfu f2bf(float f) { return (bfu)(pack2bf(f, 0.f) & 0xffffu); }
__device__ __forceinline__ float bf2f(bfu b) { return __uint_as_float(((unsigned)b) << 16); }
__device__ __forceinline__ float wave_sum(float v) {
#pragma unroll
  for (int o = 32; o; o >>= 1) v += __shfl_xor(v, o);
  return v;
}
__device__ __forceinline__ float half_sum(float v) {
#pragma unroll
  for (int o = 16; o; o >>= 1) v += __shfl_xor(v, o);
  return v;
}
__device__ __forceinline__ float fexp(float x) { return __builtin_amdgcn_exp2f(x * 1.4426950408889634f); }
__device__ __forceinline__ float silu_f(float x) { return x * __builtin_amdgcn_rcpf(1.f + fexp(-x)); }
__device__ __forceinline__ float sigmoid_f(float x) { return __builtin_amdgcn_rcpf(1.f + fexp(-x)); }
__device__ __forceinline__ float gelu_f(float x) {
  float z = 0.7978845608028654f * (x + 0.044715f * x * x * x);
  float th = 1.f - 2.f * __builtin_amdgcn_rcpf(fexp(2.f * z) + 1.f);
  return 0.5f * x * (1.f + th);
}
typedef __attribute__((ext_vector_type(4))) unsigned u32x4v;
#define MFMA16(a, b, c) __builtin_amdgcn_mfma_f32_16x16x32_bf16((a), (b), (c), 0, 0, 0)
#define MFMA32(a, b, c) __builtin_amdgcn_mfma_f32_32x32x16_bf16((a), (b), (c), 0, 0, 0)

enum { MODE_ID = 0, MODE_WIN = 1, MODE_WUQ = 2 };
template <int MODE> __device__ __forceinline__ int colmap(int n) {
  if (MODE == MODE_WIN) {
    if (n < 1408) return n;
    if (n < 1920) return 1440 + (n - 1408);
    if (n < 1952) return 1408 + (n - 1920);
    return -1;
  } else if (MODE == MODE_WUQ) {
    if (n < 512) return (n >> 6) * 96 + (n & 63);
    int m = n - 512;
    return (m >> 5) * 96 + 64 + (m & 31);
  }
  return n;
}
template <int MODE>
__device__ void prep_wT(bfu* dst, const float* src, const float* gain, const float* gain2, int ksplit,
                        int Npad, int K, int ldsrc, long gtid, long gsz) {
  const long total = (long)Npad * (K >> 3);
  for (long idx = gtid; idx < total; idx += gsz) {
    const int kbl = (int)(idx & 7);
    const long i2 = idx >> 3;
    int n = (int)(i2 % Npad), kb = (int)(i2 / Npad) * 8 + kbl;
    int sc = colmap<MODE>(n);
    bf16x8 o;
#pragma unroll
    for (int j = 0; j < 8; ++j) {
      int k = kb * 8 + j;
      float v = 0.f;
      if (sc >= 0) {
        v = src[(long)k * ldsrc + sc];
        if (gain) v *= (k < ksplit) ? gain[k] : gain2[k - ksplit];
      }
      o[j] = (short)f2bf(v);
    }
    *(bf16x8*)(dst + (long)n * K + kb * 8) = o;
  }
}
__device__ __forceinline__ void ssm_xy(const Params& p, int g, int pp, float& x, float& y) {
  float dt = expf(p.in[10][g]);
  x = p.in[8][g * 64 + pp] * dt;
  y = p.in[9][g * 64 + pp] * dt;
}
__device__ __forceinline__ float2 cpowk(float x, float y, float k) {
  float e = expf(k * x), s, c;
  sincosf(k * y, &s, &c);
  return make_float2(e * c, e * s);
}
__device__ __forceinline__ float2 ssm_coef(const Params& p, int g, int pp, float x, float y) {
  float lr = p.in[8][g * 64 + pp], li = p.in[9][g * 64 + pp];
  float s, c;
  sincosf(y, &s, &c);
  float sh = sinf(0.5f * y);
  float ar = expm1f(x) * c - 2.f * sh * sh, ai = expf(x) * s;
  float d = 1.f / (lr * lr + li * li);
  return make_float2((ar * lr + ai * li) * d, (ai * lr - ar * li) * d);
}
__device__ __forceinline__ float2 cmul(float2 a, float2 b) { return make_float2(a.x * b.x - a.y * b.y, a.x * b.y + a.y * b.x); }

__device__ void phase0(const Params& p, unsigned char* smem) {
  const int tid = threadIdx.x, lane = tid & 63, wave = tid >> 6;
  const long gtid = (long)blockIdx.x * 256 + tid, gsz = (long)gridDim.x * 256;
  unsigned char* ws = p.ws;
  {
    float* rstd = (float*)(ws + OFF_RSTD);
    const int lane = tid & 63, wave = tid >> 6;
    for (int grp = blockIdx.x; grp < NTOK / 64; grp += gridDim.x) {
      for (int sub0 = 0; sub0 < 16; sub0 += 4) {
        float4 v[4][4];
#pragma unroll
        for (int u = 0; u < 4; ++u) {
          const int row = grp * 64 + (sub0 + u) * 4 + wave;
          const float* x = row < NP ? p.in[0] + (long)row * 1024 : p.in[1] + (long)(row - NP) * 1024;
#pragma unroll
          for (int i = 0; i < 4; ++i) v[u][i] = ((const float4*)x)[lane + 64 * i];
        }
#pragma unroll
        for (int u = 0; u < 4; ++u) {
          const int row = grp * 64 + (sub0 + u) * 4 + wave;
          bfu* xb = (bfu*)(ws + OFF_XB) + (long)row * 1024;
          float ss = 0.f;
#pragma unroll
          for (int i = 0; i < 4; ++i) {
            ss += v[u][i].x * v[u][i].x + v[u][i].y * v[u][i].y + v[u][i].z * v[u][i].z + v[u][i].w * v[u][i].w;
            ((uint2*)xb)[lane + 64 * i] = make_uint2(pack2bf(v[u][i].x, v[u][i].y), pack2bf(v[u][i].z, v[u][i].w));
          }
          ss = wave_sum(ss);
          if (lane == 0) rstd[row] = rsqrtf(ss * (1.f / 1024.f) + EPS);
        }
      }
    }
  }
  prep_wT<MODE_WIN>((bfu*)(ws + OFF_WIN), p.in[7], p.in[6], p.in[6], 1 << 30, 2048, 1024, 1952, gtid, gsz);
  prep_wT<MODE_WUQ>((bfu*)(ws + OFF_WUQ), p.in[20], p.in[18], p.in[18], 1 << 30, 768, 256, 768, gtid, gsz);
  prep_wT<MODE_ID>((bfu*)(ws + OFF_WUKV), p.in[21], nullptr, nullptr, 0, 1024, 128, 1024, gtid, gsz);
  prep_wT<MODE_ID>((bfu*)(ws + OFF_WGLU), p.in[16], nullptr, nullptr, 0, 512, 512, 512, gtid, gsz);
  prep_wT<MODE_ID>((bfu*)(ws + OFF_WOUT), p.in[28], p.in[26], p.in[27], 512, 1024, 1024, 1024, gtid, gsz);
  {
    bfu* ckvb = (bfu*)(ws + OFF_CKVB);
    for (long idx = gtid; idx < 32L * 1024 * 16; idx += gsz) {
      int c8 = (int)(idx & 15), t = (int)((idx >> 4) & 1023), b = (int)(idx >> 14);
      const float* s = p.in[2] + ((long)(b * 1024 + t) * 128 + c8 * 8);
      bf16x8 o;
#pragma unroll
      for (int j = 0; j < 8; ++j) o[j] = (short)f2bf(s[j]);
      *(bf16x8*)(ckvb + ((long)(NP + b * 1056 + t) * 128 + c8 * 8)) = o;
    }
    bfu* krb = (bfu*)(ws + OFF_KRB);
    for (long idx = gtid; idx < 32L * 1024 * 4; idx += gsz) {
      int c8 = (int)(idx & 3), t = (int)((idx >> 2) & 1023), b = (int)(idx >> 12);
      const float* s = p.in[3] + ((long)(b * 1024 + t) * 32 + c8 * 8);
      bf16x8 o;
#pragma unroll
      for (int j = 0; j < 8; ++j) o[j] = (short)f2bf(s[j]);
      *(bf16x8*)(krb + ((long)(NP + b * 1056 + t) * 32 + c8 * 8)) = o;
    }
  }
  {
    bfu* mt = (bfu*)(ws + OFF_MT);
    for (long idx = gtid; idx < 32L * 128 * 32; idx += gsz) {
      int s = (int)(idx & 31), n = (int)((idx >> 5) & 127), g = (int)(idx >> 12);
      int pp = n & 63;
      float x, y;
      ssm_xy(p, g, pp, x, y);
      float2 w = cmul(cpowk(x, y, (float)(31 - s)), ssm_coef(p, g, pp, x, y));
      bf16x8 o0, o1;
#pragma unroll
      for (int c = 0; c < 16; ++c) {
        float br = p.in[11][(g * 64 + pp) * 16 + c], bi = p.in[12][(g * 64 + pp) * 16 + c];
        float v = (n < 64) ? (w.x * br - w.y * bi) : (w.x * bi + w.y * br);
        if (c < 8) o0[c] = (short)f2bf(v); else o1[c - 8] = (short)f2bf(v);
      }
      bfu* d = mt + ((long)(g * 128 + n) * 512 + s * 16);
      *(bf16x8*)d = o0;
      *(bf16x8*)(d + 8) = o1;
    }
    bfu* et = (bfu*)(ws + OFF_ET);
    for (long idx = gtid; idx < 32L * 512 * 16; idx += gsz) {
      int kb = (int)(idx & 15), n = (int)((idx >> 4) & 511), g = (int)(idx >> 13);
      int t = n >> 4, cp = n & 15;
      unsigned long long w0 = 0ULL, w1 = 0ULL;
#pragma unroll 1
      for (int j = 0; j < 8; ++j) {
        int k = kb * 8 + j, pp = k & 63;
        float x, y;
        ssm_xy(p, g, pp, x, y);
        float2 a = cpowk(x, y, (float)(t + 1));
        float cr = p.in[13][(g * 16 + cp) * 64 + pp], ci = p.in[14][(g * 16 + cp) * 64 + pp];
        float v = (k < 64) ? (cr * a.x - ci * a.y) : -(cr * a.y + ci * a.x);
        const unsigned long long bb = (unsigned long long)f2bf(v);
        if (j < 4) w0 |= bb << (16 * j); else w1 |= bb << (16 * (j - 4));
      }
      *(uint4*)(et + ((long)(g * 512 + n) * 128 + kb * 8)) = make_uint4((unsigned)w0, (unsigned)(w0 >> 32), (unsigned)w1, (unsigned)(w1 >> 32));
    }
    float2* a32 = (float2*)(ws + OFF_A32);
    for (long idx = gtid; idx < 2048; idx += gsz) {
      int g = (int)(idx >> 6), pp = (int)(idx & 63);
      float x, y;
      ssm_xy(p, g, pp, x, y);
      a32[idx] = cpowk(x, y, 32.f);
    }
    bfu* ktab = (bfu*)(ws + OFF_KTAB);
    float* sW = (float*)smem;
    for (int it = blockIdx.x; it < 32 * 33; it += gridDim.x) {
      int g = it / 33, li = it % 33;
      if (tid < 64 && li > 0) {
        float x, y;
        ssm_xy(p, g, tid, x, y);
        float2 w = cmul(cpowk(x, y, (float)(li - 1)), ssm_coef(p, g, tid, x, y));
        sW[2 * tid] = w.x;
        sW[2 * tid + 1] = w.y;
      }
      __syncthreads();
      int cp = tid >> 4, c = tid & 15;
      float sum = 0.f;
      if (li > 0) {
        for (int pp = 0; pp < 64; ++pp) {
          float wr = sW[2 * pp], wi = sW[2 * pp + 1];
          float br = p.in[11][(g * 64 + pp) * 16 + c], bi = p.in[12][(g * 64 + pp) * 16 + c];
          float cr = p.in[13][(g * 16 + cp) * 64 + pp], ci = p.in[14][(g * 16 + cp) * 64 + pp];
          float wbr = wr * br - wi * bi, wbi = wr * bi + wi * br;
          sum += cr * wbr - ci * wbi;
        }
      }
      ktab[(long)(g * 33 + li) * 256 + cp * 16 + c] = f2bf(sum);
      __syncthreads();
    }
  }
}

struct GemmOp {
  const bfu* A;
  const bfu* A_hi;
  int lda, ksplit;
  const bfu* Bt;
  int ldb, K;
};

template <bool RESCALE>
__device__ __forceinline__ void gemm_tile(const GemmOp& g, int m0, int n0, unsigned char* smem, const float* sRatio) {
  const int tid = threadIdx.x, lane = tid & 63, wave = tid >> 6;
  const int wr = wave >> 1, wc = wave & 1, r = lane & 15, q = lane >> 4;
  bfu* sA0 = (bfu*)smem;
  bfu* sB0 = sA0 + TILE_E;
  bfu* sA1 = sB0 + TILE_E;
  bfu* sB1 = sA1 + TILE_E;
  f32x4 acc[4][4];
#pragma unroll
  for (int i = 0; i < 4; ++i)
#pragma unroll
    for (int j = 0; j < 4; ++j) acc[i][j] = (f32x4){0.f, 0.f, 0.f, 0.f};
  const int lrow = tid >> 3, lkc = (tid & 7) * 8;
  u32x4v ra0, ra1, ra2, ra3, rb0, rb1, rb2, rb3;
  const int nk = g.K >> 6;
  const unsigned offA = (unsigned)(lrow * g.lda + lkc), offB = (unsigned)(lrow * g.ldb + lkc);
  const unsigned stepA = (unsigned)(32 * g.lda), stepB = (unsigned)(32 * g.ldb);
  const bfu* Alo = g.A + (long)m0 * g.lda;
  const bfu* Ahi = g.A_hi + (long)m0 * g.lda - g.ksplit;
  const bfu* Bb = g.Bt + (long)n0 * g.ldb;
#define GLD8(Ab_, Bk_) do { \
    ra0 = *(const u32x4v*)((Ab_) + offA); ra1 = *(const u32x4v*)((Ab_) + (offA + stepA)); \
    ra2 = *(const u32x4v*)((Ab_) + (offA + 2 * stepA)); ra3 = *(const u32x4v*)((Ab_) + (offA + 3 * stepA)); \
    rb0 = *(const u32x4v*)((Bk_) + offB); rb1 = *(const u32x4v*)((Bk_) + (offB + stepB)); \
    rb2 = *(const u32x4v*)((Bk_) + (offB + 2 * stepB)); rb3 = *(const u32x4v*)((Bk_) + (offB + 3 * stepB)); } while (0)
#define LST8(dA_, dB_) do { \
    *(u32x4v*)((dA_) + lrow * TSTR + lkc) = ra0; *(u32x4v*)((dA_) + (lrow + 32) * TSTR + lkc) = ra1; \
    *(u32x4v*)((dA_) + (lrow + 64) * TSTR + lkc) = ra2; *(u32x4v*)((dA_) + (lrow + 96) * TSTR + lkc) = ra3; \
    *(u32x4v*)((dB_) + lrow * TSTR + lkc) = rb0; *(u32x4v*)((dB_) + (lrow + 32) * TSTR + lkc) = rb1; \
    *(u32x4v*)((dB_) + (lrow + 64) * TSTR + lkc) = rb2; *(u32x4v*)((dB_) + (lrow + 96) * TSTR + lkc) = rb3; } while (0)
  {
    const bfu* Ab = (0 < g.ksplit) ? Alo : Ahi;
    GLD8(Ab, Bb);
    LST8(sA0, sB0);
  }
  __syncthreads();
  for (int kt = 0; kt < nk; ++kt) {
    {
      const int k1 = ((kt + 1 < nk) ? (kt + 1) : kt) << 6;
      const bfu* Ab = ((k1 < g.ksplit) ? Alo : Ahi) + k1;
      const bfu* Bk = Bb + k1;
      GLD8(Ab, Bk);
    }
    asm volatile("" ::: "memory");
    __builtin_amdgcn_sched_barrier(0);
    const bfu* cA = (kt & 1) ? sA1 : sA0;
    const bfu* cB = (kt & 1) ? sB1 : sB0;
#pragma unroll
    for (int ks = 0; ks < 2; ++ks) {
      bf16x8 af[4], bfr[4];
#pragma unroll
      for (int i = 0; i < 4; ++i) {
        af[i] = *(const bf16x8*)(cA + (wr * 64 + i * 16 + r) * TSTR + ks * 32 + q * 8);
        bfr[i] = *(const bf16x8*)(cB + (wc * 64 + i * 16 + r) * TSTR + ks * 32 + q * 8);
      }
#pragma unroll
      for (int i = 0; i < 4; ++i)
#pragma unroll
        for (int j = 0; j < 4; ++j) acc[i][j] = MFMA16(af[i], bfr[j], acc[i][j]);
    }
    if (RESCALE) {
      if (((kt + 1) << 6) == g.ksplit) {
#pragma unroll
        for (int i = 0; i < 4; ++i)
#pragma unroll
          for (int e = 0; e < 4; ++e) {
            float sc = sRatio[wr * 64 + i * 16 + q * 4 + e];
#pragma unroll
            for (int j = 0; j < 4; ++j) acc[i][j][e] *= sc;
          }
      }
    }
    asm volatile("" ::: "memory");
    __builtin_amdgcn_sched_barrier(0);
    {
      bfu* nA = (kt & 1) ? sA0 : sA1;
      bfu* nB = (kt & 1) ? sB0 : sB1;
      LST8(nA, nB);
    }
    __syncthreads();
  }
  float* Cs = (float*)smem;
#pragma unroll
  for (int i = 0; i < 4; ++i)
#pragma unroll
    for (int j = 0; j < 4; ++j)
#pragma unroll
      for (int e = 0; e < 4; ++e) Cs[(wr * 64 + i * 16 + q * 4 + e) * CSTR + wc * 64 + j * 16 + r] = acc[i][j][e];
  __syncthreads();
}

__device__ __forceinline__ void gemm_tile_x(const float* __restrict__ X, const bfu* __restrict__ Bt, int n0,
                                            unsigned char* smem) {
  const int tid = threadIdx.x, lane = tid & 63, wave = tid >> 6;
  const int wr = wave >> 1, wc = wave & 1, r = lane & 15, q = lane >> 4;
  bfu* sA0 = (bfu*)smem;
  bfu* sB0 = sA0 + TILE_E;
  bfu* sA1 = sB0 + TILE_E;
  bfu* sB1 = sA1 + TILE_E;
  f32x4 acc[4][4];
#pragma unroll
  for (int i = 0; i < 4; ++i)
#pragma unroll
    for (int j = 0; j < 4; ++j) acc[i][j] = (f32x4){0.f, 0.f, 0.f, 0.f};
  const int arow = tid >> 4, af4 = (tid & 15) * 4;
  const int lrow = tid >> 3, lkc = (tid & 7) * 8;
  f32x4 xa0, xa1, xa2, xa3, xa4, xa5, xa6, xa7;
  u32x4v rb0, rb1, rb2, rb3;
  const unsigned offA = (unsigned)(arow * 1024 + af4), offB = (unsigned)(lrow * 1024 + lkc);
  const bfu* Bb = Bt + (long)n0 * 1024;
#define XCVT(dst, v) do { *(uint2*)(dst) = make_uint2(pack2bf((v).x, (v).y), pack2bf((v).z, (v).w)); } while (0)
#define XLD(Xk_, Bk_) do { \
    xa0 = *(const f32x4*)((Xk_) + offA); xa1 = *(const f32x4*)((Xk_) + (offA + 16384u)); \
    xa2 = *(const f32x4*)((Xk_) + (offA + 32768u)); xa3 = *(const f32x4*)((Xk_) + (offA + 49152u)); \
    xa4 = *(const f32x4*)((Xk_) + (offA + 65536u)); xa5 = *(const f32x4*)((Xk_) + (offA + 81920u)); \
    xa6 = *(const f32x4*)((Xk_) + (offA + 98304u)); xa7 = *(const f32x4*)((Xk_) + (offA + 114688u)); \
    rb0 = *(const u32x4v*)((Bk_) + offB); rb1 = *(const u32x4v*)((Bk_) + (offB + 32768u)); \
    rb2 = *(const u32x4v*)((Bk_) + (offB + 65536u)); rb3 = *(const u32x4v*)((Bk_) + (offB + 98304u)); } while (0)
#define XST(dA_, dB_) do { \
    XCVT((dA_) + arow * TSTR + af4, xa0); XCVT((dA_) + (arow + 16) * TSTR + af4, xa1); \
    XCVT((dA_) + (arow + 32) * TSTR + af4, xa2); XCVT((dA_) + (arow + 48) * TSTR + af4, xa3); \
    XCVT((dA_) + (arow + 64) * TSTR + af4, xa4); XCVT((dA_) + (arow + 80) * TSTR + af4, xa5); \
    XCVT((dA_) + (arow + 96) * TSTR + af4, xa6); XCVT((dA_) + (arow + 112) * TSTR + af4, xa7); \
    *(u32x4v*)((dB_) + lrow * TSTR + lkc) = rb0; *(u32x4v*)((dB_) + (lrow + 32) * TSTR + lkc) = rb1; \
    *(u32x4v*)((dB_) + (lrow + 64) * TSTR + lkc) = rb2; *(u32x4v*)((dB_) + (lrow + 96) * TSTR + lkc) = rb3; } while (0)
  XLD(X, Bb);
  XST(sA0, sB0);
  __syncthreads();
  for (int kt = 0; kt < 16; ++kt) {
    {
      const int k1 = ((kt + 1 < 16) ? (kt + 1) : kt) << 6;
      const float* Xk = X + k1;
      const bfu* Bk = Bb + k1;
      XLD(Xk, Bk);
    }
    asm volatile("" ::: "memory");
    __builtin_amdgcn_sched_barrier(0);
    const bfu* cA = (kt & 1) ? sA1 : sA0;
    const bfu* cB = (kt & 1) ? sB1 : sB0;
#pragma unroll
    for (int ks = 0; ks < 2; ++ks) {
      bf16x8 af[4], bfr[4];
#pragma unroll
      for (int i = 0; i < 4; ++i) {
        af[i] = *(const bf16x8*)(cA + (wr * 64 + i * 16 + r) * TSTR + ks * 32 + q * 8);
        bfr[i] = *(const bf16x8*)(cB + (wc * 64 + i * 16 + r) * TSTR + ks * 32 + q * 8);
      }
#pragma unroll
      for (int i = 0; i < 4; ++i)
#pragma unroll
        for (int j = 0; j < 4; ++j) acc[i][j] = MFMA16(af[i], bfr[j], acc[i][j]);
    }
    asm volatile("" ::: "memory");
    __builtin_amdgcn_sched_barrier(0);
    {
      bfu* nA = (kt & 1) ? sA0 : sA1;
      bfu* nB = (kt & 1) ? sB0 : sB1;
      XST(nA, nB);
    }
    __syncthreads();
  }
  float* Cs = (float*)smem;
#pragma unroll
  for (int i = 0; i < 4; ++i)
#pragma unroll
    for (int j = 0; j < 4; ++j)
#pragma unroll
      for (int e = 0; e < 4; ++e) Cs[(wr * 64 + i * 16 + q * 4 + e) * CSTR + wc * 64 + j * 16 + r] = acc[i][j][e];
  __syncthreads();
}

__device__ __forceinline__ void rope_sc(float pos, int i, float& sn, float& cs) {
  float inv = exp2f(-(float)i * 0.8304820237218406f);
  sincosf(pos * inv, &sn, &cs);
}

__device__ void epi_win(const Params& p, int m0, int n0, const float* Cs) {
  const int tid = threadIdx.x, lane = tid & 63, wave = tid >> 6;
  unsigned char* ws = p.ws;
  const int nt = n0 >> 7;
  const float rs_all = ((const float*)(ws + OFF_RSTD))[m0 + wave + 4 * (lane & 31)];
  for (int rr = wave; rr < 128; rr += 4) {
    const int row = m0 + rr;
    const float rs = __shfl(rs_all, rr >> 2);
    float v0 = Cs[rr * CSTR + lane] * rs, v1 = Cs[rr * CSTR + 64 + lane] * rs;
    const bool samp = row >= NP;
    int b, t;
    if (!samp) { b = row >> 11; t = row & 2047; } else { int q_ = row - NP; b = q_ >> 5; t = q_ & 31; }
    const long kvrow = samp ? (long)(NP + b * 1056 + 1024 + t) : (long)row;
    if (nt < 4) {
      bfu* ug = (bfu*)(ws + OFF_UG);
      const int R = samp ? 1024 + b : b * 64 + (t >> 5);
      const int s = samp ? t : (t & 31);
      const int c0 = n0 + lane, c1 = c0 + 64;
      ug[((long)((c0 >> 4) * 1056 + R) * 512) + s * 16 + (c0 & 15)] = f2bf(v0);
      ug[((long)((c1 >> 4) * 1056 + R) * 512) + s * 16 + (c1 & 15)] = f2bf(v1);
    } else if (nt < 8) {
      bfu* gs = (bfu*)(ws + OFF_GS);
      gs[(long)row * 512 + (n0 - 512) + lane] = f2bf(silu_f(v0));
      gs[(long)row * 512 + (n0 - 512) + 64 + lane] = f2bf(silu_f(v1));
    } else if (nt < 10) {
      bfu* cq = (bfu*)(ws + OFF_CQ);
      cq[(long)row * 256 + (n0 - 1024) + lane] = f2bf(v0);
      cq[(long)row * 256 + (n0 - 1024) + 64 + lane] = f2bf(v1);
      float ss = wave_sum(v0 * v0 + v1 * v1);
      if (lane == 0) ((float*)(ws + OFF_SSQQ))[(long)(nt - 8) * NTOK + row] = ss;
    } else if (nt == 10) {
      float ss = wave_sum(v0 * v0 + v1 * v1);
      float rn = rsqrtf(ss * (1.f / 128.f) + EPS);
      float y0 = v0 * rn * p.in[19][lane], y1 = v1 * rn * p.in[19][lane + 64];
      float* o = samp ? p.out + O_CKVS + (long)(row - NP) * 128 : p.out + O_CKVP + (long)row * 128;
      o[lane] = y0;
      o[lane + 64] = y1;
      bfu* ckvb = (bfu*)(ws + OFF_CKVB);
      ckvb[kvrow * 128 + lane] = f2bf(y0);
      ckvb[kvrow * 128 + 64 + lane] = f2bf(y1);
    } else if (nt < 15) {
      bfu* gm = (bfu*)(ws + OFF_GM);
      gm[(long)row * 512 + (n0 - 1408) + lane] = f2bf(silu_f(v0));
      gm[(long)row * 512 + (n0 - 1408) + 64 + lane] = f2bf(silu_f(v1));
    } else {
      float v = lane < 32 ? v0 : 0.f;
      float ss = wave_sum(v * v);
      float rn = rsqrtf(ss * (1.f / 32.f) + EPS);
      float y = v * rn * p.in[25][lane & 31];
      float pr = __shfl_xor(y, 16);
      float sn, cs;
      rope_sc(samp ? (float)(1024 + t) : (float)t, lane & 15, sn, cs);
      float o = (lane & 16) ? (pr * sn + y * cs) : (y * cs - pr * sn);
      if (lane < 32) {
        float* op = samp ? p.out + O_KRS + (long)(row - NP) * 32 : p.out + O_KRP + (long)row * 32;
        op[lane] = o;
        ((bfu*)(ws + OFF_KRB))[kvrow * 32 + lane] = f2bf(o);
      }
    }
  }
}

#define QSCALE 0.14724444618947659f

__device__ void epi_q(const Params& p, int m0, int n0, const float* Cs) {
  const int tid = threadIdx.x, lane = tid & 63, wave = tid >> 6;
  unsigned char* ws = p.ws;
  const int nt = n0 >> 7;
  const float* ssqq = (const float*)(ws + OFF_SSQQ);
  bfu* qb = (bfu*)(ws + OFF_QB);
  const float rq_all = rsqrtf((ssqq[m0 + wave + 4 * (lane & 31)] + ssqq[NTOK + m0 + wave + 4 * (lane & 31)]) * (1.f / 256.f) + EPS);
  for (int rr = wave; rr < 128; rr += 4) {
    const int row = m0 + rr;
    const float rq = __shfl(rq_all, rr >> 2);
    float v0 = Cs[rr * CSTR + lane] * rq, v1 = Cs[rr * CSTR + 64 + lane] * rq;
    if (nt < 4) {
      float s0 = wave_sum(v0 * v0), s1 = wave_sum(v1 * v1);
      float gq = p.in[22][lane] * QSCALE;
      float y0 = v0 * rsqrtf(s0 * (1.f / 64.f) + EPS) * gq;
      float y1 = v1 * rsqrtf(s1 * (1.f / 64.f) + EPS) * gq;
      qb[(long)row * 768 + (2 * nt) * 96 + lane] = f2bf(y0);
      qb[(long)row * 768 + (2 * nt + 1) * 96 + lane] = f2bf(y1);
    } else {
      const int hb = (nt - 4) * 4, d = lane & 31;
      float s0 = half_sum(v0 * v0), s1 = half_sum(v1 * v1);
      float gq = p.in[24][d];
      float y0 = v0 * rsqrtf(s0 * (1.f / 32.f) + EPS) * gq;
      float y1 = v1 * rsqrtf(s1 * (1.f / 32.f) + EPS) * gq;
      float p0 = __shfl_xor(y0, 16), p1 = __shfl_xor(y1, 16);
      float pos = row < NP ? (float)(row & 2047) : (float)(1024 + ((row - NP) & 31));
      float sn, cs;
      rope_sc(pos, lane & 15, sn, cs);
      float o0 = (lane & 16) ? (p0 * sn + y0 * cs) : (y0 * cs - p0 * sn);
      float o1 = (lane & 16) ? (p1 * sn + y1 * cs) : (y1 * cs - p1 * sn);
      qb[(long)row * 768 + (hb + (lane >> 5)) * 96 + 64 + d] = f2bf(o0 * QSCALE);
      qb[(long)row * 768 + (hb + 2 + (lane >> 5)) * 96 + 64 + d] = f2bf(o1 * QSCALE);
    }
  }
}

__device__ void epi_kv(const Params& p, int m0, int n0, const float* Cs) {
  const int tid = threadIdx.x, lane = tid & 63, wave = tid >> 6;
  unsigned char* ws = p.ws;
  const int h = n0 >> 7;
  const bfu* krb = (const bfu*)(ws + OFF_KRB);
  const float gkn = p.in[23][lane];
  for (int rr0 = wave; rr0 < 128; rr0 += 16) {
    bfu kr[4];
#pragma unroll
    for (int u = 0; u < 4; ++u) kr[u] = krb[(long)(m0 + rr0 + 4 * u) * 32 + (lane & 31)];
#pragma unroll
    for (int u = 0; u < 4; ++u) {
      const int rr = rr0 + 4 * u;
      const long kvrow = m0 + rr;
      bfu* kd;
      if (kvrow < NP) {
        int b = (int)(kvrow >> 11), t = (int)(kvrow & 2047);
        kd = (bfu*)(ws + OFF_KFP) + ((long)((b * 8 + h) * 2048 + t)) * 96;
      } else {
        int ks = (int)(kvrow - NP);
        int b = ks / 1056, tt = ks % 1056;
        kd = (bfu*)(ws + OFF_KFS) + ((long)((b * 8 + h) * 1056 + tt)) * 96;
      }
      float v0 = Cs[rr * CSTR + lane];
      float ss = wave_sum(v0 * v0);
      float y = v0 * rsqrtf(ss * (1.f / 64.f) + EPS) * gkn;
      kd[lane] = f2bf(y);
      if (lane < 32) kd[64 + lane] = kr[u];
    }
  }
  for (int vc = wave; vc < 64; vc += 4) {
#pragma unroll
    for (int hf = 0; hf < 2; ++hf) {
      const int rr = lane + 64 * hf;
      const long kvrow = m0 + rr;
      bfu* vd;
      if (kvrow < NP) {
        int b = (int)(kvrow >> 11), t = (int)(kvrow & 2047);
        vd = (bfu*)(ws + OFF_VTP) + ((long)((b * 8 + h) * 64 + vc)) * 2048 + t;
      } else {
        int ks = (int)(kvrow - NP);
        int b = ks / 1056, tt = ks % 1056;
        vd = (bfu*)(ws + OFF_VTS) + ((long)((b * 8 + h) * 64 + vc)) * 1056 + tt;
      }
      *vd = f2bf(Cs[rr * CSTR + 64 + vc]);
    }
  }
}

__device__ void epi_glu(const Params& p, int m0, int n0, const float* Cs) {
  const int tid = threadIdx.x, lane = tid & 63, wave = tid >> 6;
  unsigned char* ws = p.ws;
  const int nt = n0 >> 7;
  const bfu* yg = (const bfu*)(ws + OFF_YG);
  const bfu* gs = (const bfu*)(ws + OFF_GS);
  bfu* a1 = (bfu*)(ws + OFF_A1);
  const int c0 = n0 + lane, c1 = c0 + 64;
  const float bg0 = p.in[17][c0], bg1 = p.in[17][c1];
  for (int rr0 = wave; rr0 < 128; rr0 += 16) {
    bfu y0[4], y1[4], g0[4], g1[4];
#pragma unroll
    for (int u = 0; u < 4; ++u) {
      const long row = m0 + rr0 + 4 * u;
      y0[u] = yg[row * 512 + c0]; y1[u] = yg[row * 512 + c1];
      g0[u] = gs[row * 512 + c0]; g1[u] = gs[row * 512 + c1];
    }
#pragma unroll
    for (int u = 0; u < 4; ++u) {
      const int rr = rr0 + 4 * u;
      const long row = m0 + rr;
      float z0 = Cs[rr * CSTR + lane] + bg0, z1 = Cs[rr * CSTR + 64 + lane] + bg1;
      float o0 = bf2f(y0[u]) * sigmoid_f(z0);
      float o1 = bf2f(y1[u]) * sigmoid_f(z1);
      float ss = wave_sum(o0 * o0 + o1 * o1);
      if (lane == 0) ((float*)(ws + OFF_SSQ1))[(long)nt * NTOK + row] = ss;
      a1[row * 512 + c0] = f2bf(o0 * bf2f(g0[u]));
      a1[row * 512 + c1] = f2bf(o1 * bf2f(g1[u]));
    }
  }
}

__device__ void epi_out(const Params& p, int m0, int n0, const float* Cs, const float* sR2) {
  const int tid = threadIdx.x, lane = tid & 63, wave = tid >> 6;
  for (int rr0 = wave; rr0 < 128; rr0 += 16) {
    float x0[4], x1[4];
#pragma unroll
    for (int u = 0; u < 4; ++u) {
      const int row = m0 + rr0 + 4 * u;
      const float* x = row < NP ? p.in[0] + (long)row * 1024 : p.in[1] + (long)(row - NP) * 1024;
      x0[u] = x[n0 + lane]; x1[u] = x[n0 + 64 + lane];
    }
#pragma unroll
    for (int u = 0; u < 4; ++u) {
      const int rr = rr0 + 4 * u;
      const int row = m0 + rr;
      const float r2 = sR2[rr];
      float* o = row < NP ? p.out + O_YP + (long)row * 1024 : p.out + O_YS + (long)(row - NP) * 1024;
      o[n0 + lane] = x0[u] + r2 * Cs[rr * CSTR + lane];
      o[n0 + 64 + lane] = x1[u] + r2 * Cs[rr * CSTR + 64 + lane];
    }
  }
}

struct AttnState {
  f32x16 o0, o1;
  float m, l;
};

__device__ __forceinline__ void attn_step(AttnState& st, const bf16x8 (&qf)[6], const bf16x8 (&kf)[6], const bf16x8 (&vf)[2][2]) {
  f32x16 s;
#pragma unroll
  for (int i = 0; i < 16; ++i) s[i] = 0.f;
#pragma unroll
  for (int k = 0; k < 6; ++k) s = MFMA32(kf[k], qf[k], s);
  float mx = s[0];
#pragma unroll
  for (int i = 1; i < 16; ++i) mx = fmaxf(mx, s[i]);
  mx = fmaxf(mx, __shfl_xor(mx, 32));
  const float mn = fmaxf(st.m, mx);
  const float alpha = __builtin_amdgcn_exp2f(st.m - mn);
  st.m = mn;
  float ls = 0.f;
  u32x4v pw0, pw1;
#pragma unroll
  for (int i = 0; i < 16; i += 2) {
    float e0 = __builtin_amdgcn_exp2f(s[i] - mn), e1 = __builtin_amdgcn_exp2f(s[i + 1] - mn);
    ls += e0 + e1;
    const unsigned w = pack2bf(e0, e1);
    if (i < 8) pw0[i >> 1] = w; else pw1[(i - 8) >> 1] = w;
  }
  const bf16x8 pb0 = *(bf16x8*)&pw0, pb1 = *(bf16x8*)&pw1;
  st.l = st.l * alpha + ls;
#pragma unroll
  for (int i = 0; i < 16; ++i) { st.o0[i] *= alpha; st.o1[i] *= alpha; }
  st.o0 = MFMA32(vf[0][0], pb0, st.o0);
  st.o0 = MFMA32(vf[0][1], pb1, st.o0);
  st.o1 = MFMA32(vf[1][0], pb0, st.o1);
  st.o1 = MFMA32(vf[1][1], pb1, st.o1);
}

__device__ __forceinline__ void attn_finish(const Params& p, AttnState& st, float ltot, long token, int h, int lane) {
  unsigned char* ws = p.ws;
  const int hh = lane >> 5;
  const float inv = __builtin_amdgcn_rcpf(ltot);
  float ss = 0.f;
#pragma unroll
  for (int i = 0; i < 16; ++i) {
    st.o0[i] *= inv; st.o1[i] *= inv;
    ss += st.o0[i] * st.o0[i] + st.o1[i] * st.o1[i];
  }
  ss += __shfl_xor(ss, 32);
  if (hh == 0) ((float*)(ws + OFF_SSQ2))[(long)h * NTOK + token] = ss;
  const bfu* gm = (const bfu*)(ws + OFF_GM) + token * 512 + h * 64;
  bfu* a2 = (bfu*)(ws + OFF_A2) + token * 512 + h * 64;
#pragma unroll
  for (int mt = 0; mt < 2; ++mt)
#pragma unroll
    for (int g4 = 0; g4 < 4; ++g4) {
      const int v0 = 32 * mt + 8 * g4 + 4 * hh;
      ushort4 gt = *(const ushort4*)(gm + v0);
      ushort4 o;
      float a = mt ? st.o1[4 * g4 + 0] : st.o0[4 * g4 + 0];
      float b = mt ? st.o1[4 * g4 + 1] : st.o0[4 * g4 + 1];
      float c = mt ? st.o1[4 * g4 + 2] : st.o0[4 * g4 + 2];
      float d = mt ? st.o1[4 * g4 + 3] : st.o0[4 * g4 + 3];
      o.x = f2bf(a * bf2f(gt.x)); o.y = f2bf(b * bf2f(gt.y)); o.z = f2bf(c * bf2f(gt.z)); o.w = f2bf(d * bf2f(gt.w));
      *(ushort4*)(a2 + v0) = o;
    }
}

constexpr int KSTR = 104;
constexpr int VSTR = 68;

__device__ void attn_prompt_item(const Params& p, int bh, int j, unsigned char* smem) {
  const int tid = threadIdx.x, lane = tid & 63, wave = tid >> 6;
  const int r32 = lane & 31, hh = lane >> 5;
  unsigned char* ws = p.ws;
  const int b = bh >> 3, h = bh & 7;
  const long tok = (long)b * 2048 + j * 128 + wave * 32 + r32;
  const bfu* qp = (const bfu*)(ws + OFF_QB) + tok * 768 + h * 96;
  bf16x8 qf[6];
#pragma unroll
  for (int k = 0; k < 6; ++k) qf[k] = *(const bf16x8*)(qp + 16 * k + 8 * hh);
  const bfu* Kb = (const bfu*)(ws + OFF_KFP) + (long)bh * 2048 * 96;
  const bfu* Vb = (const bfu*)(ws + OFF_VTP) + (long)bh * 64 * 2048;
  bfu* sK = (bfu*)smem;
  bfu* sV = (bfu*)(smem + 2 * 64 * KSTR * 2);
  const int nkt = 2 * j + 2;
  const int my_nkt = 2 * j + (wave >> 1) + 1;
  AttnState st;
#pragma unroll
  for (int i = 0; i < 16; ++i) { st.o0[i] = 0.f; st.o1[i] = 0.f; }
  st.m = -1e30f; st.l = 0.f;
  u32x4v rk0, rk1, rk2, rv0, rv1;
  int krow[3], kcc[3];
#pragma unroll
  for (int i = 0; i < 3; ++i) { int c = tid + i * 256; krow[i] = c / 12; kcc[i] = c % 12; }
  const int vrow0 = tid >> 3, vcc = tid & 7;
  const unsigned ko0 = (unsigned)(krow[0] * 96 + kcc[0] * 8), ko1 = (unsigned)(krow[1] * 96 + kcc[1] * 8), ko2 = (unsigned)(krow[2] * 96 + kcc[2] * 8);
  const unsigned vo0 = (unsigned)(vrow0 * 2048 + vcc * 8), vo1 = vo0 + 32u * 2048u;
  const int kl0 = krow[0] * KSTR + kcc[0] * 8, kl1 = krow[1] * KSTR + kcc[1] * 8, kl2 = krow[2] * KSTR + kcc[2] * 8;
  const int vl0 = vrow0 * VSTR + vcc * 8, vl1 = (vrow0 + 32) * VSTR + vcc * 8;
#define VST(base, off, v) do { bfu* d_ = (base) + (off); *(uint2*)d_ = make_uint2((v).x, (v).y); *(uint2*)(d_ + 4) = make_uint2((v).z, (v).w); } while (0)
  rk0 = *(const u32x4v*)(Kb + ko0); rk1 = *(const u32x4v*)(Kb + ko1); rk2 = *(const u32x4v*)(Kb + ko2);
  rv0 = *(const u32x4v*)(Vb + vo0); rv1 = *(const u32x4v*)(Vb + vo1);
  *(u32x4v*)(sK + kl0) = rk0; *(u32x4v*)(sK + kl1) = rk1; *(u32x4v*)(sK + kl2) = rk2;
  VST(sV, vl0, rv0); VST(sV, vl1, rv1);
  __syncthreads();
  for (int kt = 0; kt < nkt; ++kt) {
    {
      const int kn = (kt + 1 < nkt) ? (kt + 1) : kt;
      const bfu* Kn = Kb + kn * 6144;
      const bfu* Vn = Vb + kn * 64;
      rk0 = *(const u32x4v*)(Kn + ko0); rk1 = *(const u32x4v*)(Kn + ko1); rk2 = *(const u32x4v*)(Kn + ko2);
      rv0 = *(const u32x4v*)(Vn + vo0); rv1 = *(const u32x4v*)(Vn + vo1);
    }
    asm volatile("" ::: "memory");
    __builtin_amdgcn_sched_barrier(0);
    if (kt < my_nkt) {
      const bfu* cK = sK + (kt & 1) * 64 * KSTR;
      const bfu* cV = sV + (kt & 1) * 64 * VSTR;
#pragma unroll
      for (int sub = 0; sub < 2; ++sub) {
        bf16x8 kf[6], vf[2][2];
#pragma unroll
        for (int k = 0; k < 6; ++k) kf[k] = *(const bf16x8*)(cK + (sub * 32 + r32) * KSTR + 16 * k + 8 * hh);
#pragma unroll
        for (int mt = 0; mt < 2; ++mt)
#pragma unroll
          for (int s2 = 0; s2 < 2; ++s2) {
            const bfu* vp = cV + (mt * 32 + r32) * VSTR + sub * 32 + 16 * s2 + 4 * hh;
            uint2 lo = *(const uint2*)vp, hi = *(const uint2*)(vp + 8);
            uint4 w = make_uint4(lo.x, lo.y, hi.x, hi.y);
            vf[mt][s2] = *(bf16x8*)&w;
          }
        attn_step(st, qf, kf, vf);
      }
    }
    asm volatile("" ::: "memory");
    __builtin_amdgcn_sched_barrier(0);
    {
      bfu* nK = sK + ((kt + 1) & 1) * 64 * KSTR;
      bfu* nV = sV + ((kt + 1) & 1) * 64 * VSTR;
      *(u32x4v*)(nK + kl0) = rk0; *(u32x4v*)(nK + kl1) = rk1; *(u32x4v*)(nK + kl2) = rk2;
      VST(nV, vl0, rv0); VST(nV, vl1, rv1);
    }
    __syncthreads();
  }
  attn_finish(p, st, st.l + __shfl_xor(st.l, 32), tok, h, lane);
}

__device__ void attn_sample_item(const Params& p, int bh, unsigned char* smem) {
  const int tid = threadIdx.x, lane = tid & 63, wave = tid >> 6;
  const int r32 = lane & 31, hh = lane >> 5;
  unsigned char* ws = p.ws;
  const int b = bh >> 3, h = bh & 7;
  const long tok = (long)NP + b * 32 + r32;
  const bfu* qp = (const bfu*)(ws + OFF_QB) + tok * 768 + h * 96;
  bf16x8 qf[6];
#pragma unroll
  for (int k = 0; k < 6; ++k) qf[k] = *(const bf16x8*)(qp + 16 * k + 8 * hh);
  const bfu* Kb = (const bfu*)(ws + OFF_KFS) + (long)bh * 1056 * 96;
  const bfu* Vb = (const bfu*)(ws + OFF_VTS) + (long)bh * 64 * 1056;
  float* sO = (float*)smem;
  float* sM = sO + 4 * 32 * 64;
  float* sL = sM + 128;
  AttnState st;
#pragma unroll
  for (int i = 0; i < 16; ++i) { st.o0[i] = 0.f; st.o1[i] = 0.f; }
  st.m = -1e30f; st.l = 0.f;
#pragma unroll 1
  for (int su = wave; su < 33; su += 4) {
    bf16x8 kf[6], vf[2][2];
#pragma unroll
    for (int k = 0; k < 6; ++k) kf[k] = *(const bf16x8*)(Kb + (long)(su * 32 + r32) * 96 + 16 * k + 8 * hh);
#pragma unroll
    for (int mt = 0; mt < 2; ++mt)
#pragma unroll
      for (int s2 = 0; s2 < 2; ++s2) {
        const bfu* vp = Vb + (long)(mt * 32 + r32) * 1056 + su * 32 + 16 * s2 + 4 * hh;
        uint2 lo = *(const uint2*)vp, hi = *(const uint2*)(vp + 8);
        uint4 w = make_uint4(lo.x, lo.y, hi.x, hi.y);
        vf[mt][s2] = *(bf16x8*)&w;
      }
    attn_step(st, qf, kf, vf);
  }
  float l = st.l + __shfl_xor(st.l, 32);
  if (wave > 0) {
#pragma unroll
    for (int i = 0; i < 16; ++i) {
      sO[(wave * 32 + i) * 64 + lane] = st.o0[i];
      sO[(wave * 32 + 16 + i) * 64 + lane] = st.o1[i];
    }
    if (hh == 0) { sM[wave * 32 + r32] = st.m; sL[wave * 32 + r32] = l; }
  }
  __syncthreads();
  if (wave == 0) {
    float M = st.m;
#pragma unroll
    for (int w = 1; w < 4; ++w) M = fmaxf(M, sM[w * 32 + r32]);
    const float f0 = exp2f(st.m - M);
    float L = l * f0;
#pragma unroll
    for (int i = 0; i < 16; ++i) { st.o0[i] *= f0; st.o1[i] *= f0; }
#pragma unroll
    for (int w = 1; w < 4; ++w) {
      const float fw = exp2f(sM[w * 32 + r32] - M);
      L += fw * sL[w * 32 + r32];
#pragma unroll
      for (int i = 0; i < 16; ++i) {
        st.o0[i] += fw * sO[(w * 32 + i) * 64 + lane];
        st.o1[i] += fw * sO[(w * 32 + 16 + i) * 64 + lane];
      }
    }
    attn_finish(p, st, L, tok, h, lane);
  }
  __syncthreads();
}

__device__ void ssm_item(const Params& p, int g, int b, bool samp, unsigned char* smem, int jh_lo, int jh_hi) {
  const int tid = threadIdx.x, lane = tid & 63, wave = tid >> 6;
  const int r = lane & 15, q = lane >> 4;
  unsigned char* ws = p.ws;
  float* sS = (float*)smem;
  bfu* sH = (bfu*)(smem + 32768);
  bfu* sK = (bfu*)(smem + 32768 + 17408);
  const int R0 = samp ? 1024 : b * 64;
  const bfu* Ug = (const bfu*)(ws + OFF_UG) + ((long)(g * 1056 + R0)) * 512;
  const bfu* MT = (const bfu*)(ws + OFF_MT) + (long)g * 128 * 512;
  const bfu* ET = (const bfu*)(ws + OFF_ET) + (long)g * 512 * 128;
  {
    const uint4* src = (const uint4*)((const bfu*)(ws + OFF_KTAB) + (long)g * 33 * 256);
    for (int c = tid; c < 1056; c += 256) ((uint4*)sK)[c] = src[c];
  }
  {
    f32x4 acc[4][2];
#pragma unroll
    for (int i = 0; i < 4; ++i) { acc[i][0] = (f32x4){0.f, 0.f, 0.f, 0.f}; acc[i][1] = acc[i][0]; }
    for (int ks = 0; ks < 16; ++ks) {
      bf16x8 af[4], bfr[2];
#pragma unroll
      for (int i = 0; i < 4; ++i) af[i] = *(const bf16x8*)(Ug + (long)(i * 16 + r) * 512 + ks * 32 + q * 8);
#pragma unroll
      for (int j = 0; j < 2; ++j) bfr[j] = *(const bf16x8*)(MT + (long)(wave * 32 + j * 16 + r) * 512 + ks * 32 + q * 8);
#pragma unroll
      for (int i = 0; i < 4; ++i)
#pragma unroll
        for (int j = 0; j < 2; ++j) acc[i][j] = MFMA16(af[i], bfr[j], acc[i][j]);
    }
#pragma unroll
    for (int i = 0; i < 4; ++i)
#pragma unroll
      for (int j = 0; j < 2; ++j)
#pragma unroll
        for (int e = 0; e < 4; ++e) sS[(i * 16 + q * 4 + e) * 128 + wave * 32 + j * 16 + r] = acc[i][j][e];
  }
  __syncthreads();
  {
    const float2* a32 = (const float2*)(ws + OFF_A32) + g * 64;
    if (!samp) {
      if (tid < 64) {
        const float2 a = a32[tid];
        float hr = 0.f, hi = 0.f;
        for (int c = 0; c < 64; ++c) {
          sH[c * 136 + tid] = f2bf(hr);
          sH[c * 136 + 64 + tid] = f2bf(hi);
          float sr = sS[c * 128 + tid], si = sS[c * 128 + 64 + tid];
          float nr = a.x * hr - a.y * hi + sr, ni = a.x * hi + a.y * hr + si;
          hr = nr; hi = ni;
        }
        p.out[O_REP + (long)(b * 32 + g) * 64 + tid] = hr;
        p.out[O_IMP + (long)(b * 32 + g) * 64 + tid] = hi;
      }
    } else {
      for (int idx = tid; idx < 32 * 64; idx += 256) {
        const int bb = idx >> 6, pp = idx & 63;
        const float2 a = a32[pp];
        float hr = p.in[4][(long)(bb * 32 + g) * 64 + pp], hi = p.in[5][(long)(bb * 32 + g) * 64 + pp];
        sH[bb * 136 + pp] = f2bf(hr);
        sH[bb * 136 + 64 + pp] = f2bf(hi);
        float sr = sS[bb * 128 + pp], si = sS[bb * 128 + 64 + pp];
        p.out[O_RES + (long)(bb * 32 + g) * 64 + pp] = a.x * hr - a.y * hi + sr;
        p.out[O_IMS + (long)(bb * 32 + g) * 64 + pp] = a.x * hi + a.y * hr + si;
      }
      for (int idx = tid; idx < 32 * 128; idx += 256) sH[(32 + (idx >> 7)) * 136 + (idx & 127)] = 0;
    }
  }
  __syncthreads();
  {
    const float dd = p.in[15][g * 16 + r];
    bfu* yg = (bfu*)(ws + OFF_YG);
    const int nrows = samp ? 32 : 64;
#pragma unroll 1
    for (int jh = jh_lo; jh < jh_hi; ++jh) {
      f32x4 acc[4][4];
#pragma unroll
      for (int i = 0; i < 4; ++i)
#pragma unroll
        for (int j = 0; j < 4; ++j) acc[i][j] = (f32x4){0.f, 0.f, 0.f, 0.f};
      const int tb = wave + 16 * jh;
      const int tmax = tb + 12;
#pragma unroll 1
      for (int ks = 0; ks < 16; ++ks) {
        const int s0 = 2 * ks;
        if (s0 > tmax) break;
        bf16x8 af[4];
#pragma unroll
        for (int i = 0; i < 4; ++i) af[i] = *(const bf16x8*)(Ug + (long)(i * 16 + r) * 512 + ks * 32 + q * 8);
#pragma unroll
        for (int j = 0; j < 4; ++j) {
          const int t = tb + 4 * j;
          if (t >= s0) {
            const int li = t - s0 - (q >> 1) + 1;
            bf16x8 bfr = *(const bf16x8*)(sK + li * 256 + r * 16 + (q & 1) * 8);
#pragma unroll
            for (int i = 0; i < 4; ++i) acc[i][j] = MFMA16(af[i], bfr, acc[i][j]);
          }
        }
      }
#pragma unroll 1
      for (int kc = 0; kc < 4; ++kc) {
        bf16x8 af[4];
#pragma unroll
        for (int i = 0; i < 4; ++i) af[i] = *(const bf16x8*)(sH + (i * 16 + r) * 136 + kc * 32 + q * 8);
#pragma unroll
        for (int j = 0; j < 4; ++j) {
          const int t = tb + 4 * j;
          bf16x8 bfr = *(const bf16x8*)(ET + (long)(t * 16 + r) * 128 + kc * 32 + q * 8);
#pragma unroll
          for (int i = 0; i < 4; ++i) acc[i][j] = MFMA16(af[i], bfr, acc[i][j]);
        }
      }
#pragma unroll
      for (int i = 0; i < 4; ++i) {
        bfu uu[4][4];
#pragma unroll
        for (int j = 0; j < 4; ++j)
#pragma unroll
          for (int e = 0; e < 4; ++e) {
            const int row = i * 16 + q * 4 + e, t = tb + 4 * j;
            uu[j][e] = Ug[(long)row * 512 + t * 16 + r];
          }
#pragma unroll
        for (int j = 0; j < 4; ++j)
#pragma unroll
          for (int e = 0; e < 4; ++e) {
            const int row = i * 16 + q * 4 + e, t = tb + 4 * j;
            if (row < nrows) {
              float y = acc[i][j][e] + dd * bf2f(uu[j][e]);
              long token = samp ? (long)NP + row * 32 + t : (long)b * 2048 + row * 32 + t;
              yg[token * 512 + g * 16 + r] = f2bf(gelu_f(y));
            }
          }
      }
    }
  }
  __syncthreads();
}


__device__ __forceinline__ void l2_scrub(const Params& p, unsigned char* ws, int seam) {
  const uint4* xs = (const uint4*)p.in[0] + (long)(blockIdx.x & 511) * 16384 + (seam & 1) * 8192;
  unsigned acc = 0;
#pragma unroll 8
  for (int i = threadIdx.x; i < 8192; i += 256) { uint4 v = xs[i]; acc ^= v.x ^ v.y ^ v.z ^ v.w; }
  if (acc == 0x9e3779b9u + (unsigned)seam && ws == nullptr) ((volatile unsigned*)ws)[0] = acc;
}
#define XB_TMO      128
#define XB_XCNT(j)  (256  + 64 * (j))
#define XB_XSUB(j)  (1280 + 64 * (j))
#define XB_XGEN(j)  (2304 + 64 * (j))
#define XB_TOP      3328
#define XB_TOPGEN   3392
#define XCD_BAR_WORDS 3456
#define XB_SPIN_CAP (1u << 18)
#define LAS __attribute__((address_space(3)))

__device__ __forceinline__ unsigned xb_ld(unsigned* p)              { return __hip_atomic_load(p, __ATOMIC_RELAXED, __HIP_MEMORY_SCOPE_AGENT); }
__device__ __forceinline__ unsigned xb_add(unsigned* p, unsigned v) { return __hip_atomic_fetch_add(p, v, __ATOMIC_RELAXED, __HIP_MEMORY_SCOPE_AGENT); }
__device__ __forceinline__ unsigned xb_xcc_id() { return (unsigned)__builtin_amdgcn_s_getreg((3 << 11) | 20) & 0xFu; }
#define XB_SPIN(cond, bar) do { unsigned _sp = 0; while (cond) { __builtin_amdgcn_s_sleep(1); \
    if ((++_sp & 255u) == 0u) { if (xb_ld(&(bar)[XB_TMO])) break; if (_sp > XB_SPIN_CAP) { atomicAdd(&(bar)[XB_TMO], 1u); break; } } } } while (0)

struct XcdBarrier {
    unsigned* bar; unsigned x;
    volatile LAS unsigned* st;
};

__device__ __forceinline__ XcdBarrier xcd_barrier_post(unsigned* bar, volatile LAS unsigned* st) {
    XcdBarrier b; b.bar = bar; b.x = xb_xcc_id(); b.st = st;
    if (threadIdx.x == 0) (void)xb_add(&bar[XB_XCNT(b.x)], 1u);
    return b;
}
__device__ __forceinline__ void xcd_barrier_complete(unsigned* bar, unsigned x, unsigned& nloc, unsigned& nx) {
    const unsigned G = gridDim.x * gridDim.y * gridDim.z;
    unsigned sum, cnt, mine, sp = 0u;
    for (;;) {
        sum = 0u; cnt = 0u; mine = 0u;
#pragma unroll
        for (unsigned j = 0; j < 16; ++j) { const unsigned c = xb_ld(&bar[XB_XCNT(j)]); sum += c; cnt += (c > 0u) ? 1u : 0u; mine = (j == x) ? c : mine; }
        if (sum == G) break;
        __builtin_amdgcn_s_sleep(1);
        if ((++sp & 255u) == 0u) { if (xb_ld(&bar[XB_TMO])) break; if (sp > XB_SPIN_CAP) { atomicAdd(&bar[XB_TMO], 1u); break; } }
    }
    nloc = mine > 0u ? mine : 1u; nx = cnt > 0u ? cnt : 1u;
}

__device__ __forceinline__ void xcd_barrier(const XcdBarrier& b) {
    asm volatile("s_waitcnt vmcnt(0)" ::: "memory");
    __syncthreads();
    if (threadIdx.x == 0) {
        unsigned* bar = b.bar;
        __builtin_amdgcn_s_waitcnt(0);
        unsigned nloc = b.st[0], nx = b.st[1];
        if (nloc == 0u) { xcd_barrier_complete(bar, b.x, nloc, nx); b.st[0] = nloc; b.st[1] = nx; }
        const unsigned old = xb_add(&bar[XB_XSUB(b.x)], 1u);
        const unsigned gen = old / nloc;
        if (old + 1u == (gen + 1u) * nloc) {
            __builtin_amdgcn_fence(__ATOMIC_RELEASE, "agent");
            asm volatile("s_waitcnt vmcnt(0)" ::: "memory");
            const unsigned og = xb_add(&bar[XB_TOP], 1u);
            const unsigned tg = og / nx;
            if (og + 1u == (tg + 1u) * nx) xb_add(&bar[XB_TOPGEN], 1u);
            else XB_SPIN(xb_ld(&bar[XB_TOPGEN]) == tg, bar);
            __builtin_amdgcn_fence(__ATOMIC_ACQUIRE, "agent");
            xb_add(&bar[XB_XGEN(b.x)], 1u);
            asm volatile("s_waitcnt vmcnt(0)" ::: "memory");
        } else {
            XB_SPIN(xb_ld(&bar[XB_XGEN(b.x)]) == gen, bar);
            __builtin_amdgcn_fence(__ATOMIC_ACQUIRE, "agent");
            asm volatile("s_waitcnt vmcnt(0)" ::: "memory");
        }
    }
    __syncthreads();
}


#define GRID_SYNC() do { \
    xcd_barrier(xbar); \
    ++sync_no; \
    l2_scrub(p, ws, sync_no); \
  } while (0)
#ifndef REP_P0
#define REP_P0 1
#endif
#ifndef REP_P1
#define REP_P1 1
#endif
#ifndef REP_P2
#define REP_P2 1
#endif
#ifndef REP_P3
#define REP_P3 1
#endif
#ifndef REP_P4
#define REP_P4 1
#endif
#ifndef REP_P5
#define REP_P5 1
#endif
__global__ void __launch_bounds__(256, 2) mega(Params p) {
  extern __shared__ __attribute__((aligned(16))) unsigned char smem[];
  cg::grid_group grid = cg::this_grid();
  unsigned char* ws = p.ws;
  const int G = gridDim.x, bid = blockIdx.x;
  int sync_no = 0;
  if (ws == nullptr) grid.sync();
  volatile LAS unsigned* xb_st = (volatile LAS unsigned*)(smem + 74752);
  if (threadIdx.x == 0) { xb_st[0] = 0u; xb_st[1] = 0u; xb_st[2] = 0u; xb_st[3] = 0u; }
  __syncthreads();
  const XcdBarrier xbar = xcd_barrier_post((unsigned*)(ws + OFF_BAR), xb_st);

#pragma unroll 1
  for (int rep = 0; rep < REP_P0; ++rep) {
    phase0(p, smem);
    GRID_SYNC();
  }

#pragma unroll 1
  for (int rep = 0; rep < REP_P1; ++rep) {
    GemmOp g;
    g.A = (const bfu*)(ws + OFF_XB); g.A_hi = g.A; g.lda = 1024; g.ksplit = 1 << 30;
    g.Bt = (const bfu*)(ws + OFF_WIN); g.ldb = 1024; g.K = 1024;
    for (int l = bid >> 3; l < 33 * 16; l += (G >> 3)) {
      const int m0 = ((bid & 7) + 8 * (l >> 4)) * 128, n0 = (l & 15) * 128;
      gemm_tile<false>(g, m0, n0, smem, nullptr);
      epi_win(p, m0, n0, (const float*)smem);
      __syncthreads();
    }
    GRID_SYNC();
  }

  #pragma unroll 1
  for (int rep = 0; rep < REP_P2; ++rep) {
    GemmOp gq;
    gq.A = (const bfu*)(ws + OFF_CQ); gq.A_hi = gq.A; gq.lda = 256; gq.ksplit = 1 << 30;
    gq.Bt = (const bfu*)(ws + OFF_WUQ); gq.ldb = 256; gq.K = 256;
    GemmOp gk;
    gk.A = (const bfu*)(ws + OFF_CKVB); gk.A_hi = gk.A; gk.lda = 128; gk.ksplit = 1 << 30;
    gk.Bt = (const bfu*)(ws + OFF_WUKV); gk.ldb = 128; gk.K = 128;
    const int nq = 33 * 6, nkv = 65 * 8;
    for (int l = bid >> 3; l < nq + nkv; l += (G >> 3)) {
      if (l < nq) {
        const int m0 = ((bid & 7) + 8 * (l / 6)) * 128, n0 = (l % 6) * 128;
        gemm_tile<false>(gq, m0, n0, smem, nullptr);
        epi_q(p, m0, n0, (const float*)smem);
      } else {
        const int k = l - nq;
        const int m0 = ((bid & 7) + 8 * (k >> 3)) * 128, n0 = (k & 7) * 128;
        gemm_tile<false>(gk, m0, n0, smem, nullptr);
        epi_kv(p, m0, n0, (const float*)smem);
      }
      __syncthreads();
    }
    GRID_SYNC();
  }

  #pragma unroll 1
  for (int rep = 0; rep < REP_P3; ++rep) {
    for (int it = bid; it < 256; it += G) attn_sample_item(p, it, smem);
    for (int k = G - 1 - bid; k < 576; k += G) {
      if (k < 512) ssm_item(p, k & 31, k >> 5, false, smem, 0, 2);
      else ssm_item(p, (k - 512) >> 1, 0, true, smem, (k - 512) & 1, ((k - 512) & 1) + 1);
    }
    const int rounds = (2048 + G - 1) / G;
    for (int rd = 0; rd < rounds; ++rd) {
      const int pos = (rd & 1) ? (G - 1 - bid) : bid;
      const int it = rd * G + pos;
      if (it < 2048) attn_prompt_item(p, it & 127, 15 - (it >> 7), smem);
    }
    GRID_SYNC();
  }

  #pragma unroll 1
  for (int rep = 0; rep < REP_P4; ++rep) {
    GemmOp g;
    g.A = (const bfu*)(ws + OFF_YG); g.A_hi = g.A; g.lda = 512; g.ksplit = 1 << 30;
    g.Bt = (const bfu*)(ws + OFF_WGLU); g.ldb = 512; g.K = 512;
    for (int l = bid >> 3; l < 33 * 4; l += (G >> 3)) {
      const int m0 = ((bid & 7) + 8 * (l >> 2)) * 128, n0 = (l & 3) * 128;
      gemm_tile<false>(g, m0, n0, smem, nullptr);
      epi_glu(p, m0, n0, (const float*)smem);
      __syncthreads();
    }
    GRID_SYNC();
  }

  #pragma unroll 1
  for (int rep = 0; rep < REP_P5; ++rep) {
    GemmOp g;
    g.A = (const bfu*)(ws + OFF_A1); g.A_hi = (const bfu*)(ws + OFF_A2); g.lda = 512; g.ksplit = 512;
    g.Bt = (const bfu*)(ws + OFF_WOUT); g.ldb = 1024; g.K = 1024;
    float* sRatio = (float*)(smem + 73728);
    float* sR2 = sRatio + 128;
    const float* ssq1 = (const float*)(ws + OFF_SSQ1);
    const float* ssq2 = (const float*)(ws + OFF_SSQ2);
    for (int l = bid >> 3; l < 33 * 8; l += (G >> 3)) {
      const int m0 = ((bid & 7) + 8 * (l >> 3)) * 128, n0 = (l & 7) * 128;
      if (threadIdx.x < 128) {
        const long row = m0 + threadIdx.x;
        float s1 = ssq1[row] + ssq1[NTOK + row] + ssq1[2L * NTOK + row] + ssq1[3L * NTOK + row];
        float s2 = 0.f;
#pragma unroll
        for (int i = 0; i < 8; ++i) s2 += ssq2[(long)i * NTOK + row];
        float r1 = rsqrtf(s1 * (1.f / 512.f) + EPS), r2 = rsqrtf(s2 * (1.f / 512.f) + EPS);
        sRatio[threadIdx.x] = r1 / r2;
        sR2[threadIdx.x] = r2;
      }
      gemm_tile<true>(g, m0, n0, smem, sRatio);
      epi_out(p, m0, n0, (const float*)smem, sR2);
      __syncthreads();
    }
  }
}

extern "C" void kernel_launch(void* const* d_in, const int* in_sizes, int n_in, void* d_out, int out_size,
                              void* d_ws, size_t ws_size, hipStream_t stream) {
  static int grid_blocks = 0;
  if (!grid_blocks) {
    int dev = 0, cus = 0, per_cu = 0;
    hipGetDevice(&dev);
    hipDeviceGetAttribute(&cus, hipDeviceAttributeMultiprocessorCount, dev);
    hipFuncSetAttribute((const void*)mega, hipFuncAttributeMaxDynamicSharedMemorySize, LDS_BYTES);
    hipOccupancyMaxActiveBlocksPerMultiprocessor(&per_cu, (const void*)mega, 256, LDS_BYTES);
    if (per_cu > 2) per_cu = 2;
    if (per_cu < 1) per_cu = 1;
    grid_blocks = cus * per_cu;
    if (ws_size < WS_END) fprintf(stderr, "kernel_launch: workspace too small: %zu < %zu\n", ws_size, (size_t)WS_END);
  }
  if (ws_size < WS_END) return;
  Params p{};
  for (int i = 0; i < 29; ++i) p.in[i] = (const float*)d_in[i];
  p.out = (float*)d_out;
  p.ws = (unsigned char*)d_ws;
  hipMemsetAsync((unsigned char*)d_ws + OFF_BAR, 0, BAR_BYTES, stream);
  void* args[] = {&p};
  hipError_t e = hipLaunchCooperativeKernel((const void*)mega, dim3(grid_blocks), dim3(256), args, LDS_BYTES, stream);
  if (e != hipSuccess) fprintf(stderr, "cooperative launch failed: %s (grid %d)\n", hipGetErrorString(e), grid_blocks);
}
```

```cpp
#include <hip/hip_runtime.h>
#include <hip/hip_cooperative_groups.h>
#include <cstdio>
namespace cg = cooperative_groups;

typedef unsigned short bfu;
typedef __attribute__((ext_vector_type(8))) short bf16x8;
typedef __attribute__((ext_vector_type(4))) float f32x4;
typedef __attribute__((ext_vector_type(16))) float f32x16;

#define NP 32768
#define NS 1024
#define NTOK 33792
#define NKV 66560
#define EPS 1e-6f

#define O_YP 0L
#define O_YS 33554432L
#define O_CKVP 34603008L
#define O_KRP 38797312L
#define O_REP 39845888L
#define O_IMP 39878656L
#define O_CKVS 39911424L
#define O_KRS 40042496L
#define O_RES 40075264L
#define O_IMS 40140800L

constexpr size_t al256(size_t x) { return (x + 255) & ~(size_t)255; }
constexpr size_t OFF_A2 = 0;
constexpr size_t OFF_YG = OFF_A2 + (size_t)NTOK * 512 * 2;
constexpr size_t OFF_XB = OFF_A2;
constexpr size_t OFF_A1 = al256(OFF_YG + (size_t)NTOK * 512 * 2);
constexpr size_t OFF_WIN = al256(OFF_A1 + (size_t)NTOK * 512 * 2);
constexpr size_t OFF_WUQ = al256(OFF_WIN + (size_t)2048 * 1024 * 2);
constexpr size_t OFF_WUKV = al256(OFF_WUQ + (size_t)768 * 256 * 2);
constexpr size_t OFF_WGLU = al256(OFF_WUKV + (size_t)1024 * 128 * 2);
constexpr size_t OFF_WOUT = al256(OFF_WGLU + (size_t)512 * 512 * 2);
constexpr size_t OFF_KTAB = al256(OFF_WOUT + (size_t)1024 * 1024 * 2);
constexpr size_t OFF_MT = al256(OFF_KTAB + (size_t)32 * 33 * 256 * 2);
constexpr size_t OFF_ET = al256(OFF_MT + (size_t)32 * 128 * 512 * 2);
constexpr size_t OFF_A32 = al256(OFF_ET + (size_t)32 * 512 * 128 * 2);
constexpr size_t OFF_UG = al256(OFF_A32 + (size_t)32 * 64 * 2 * 4);
constexpr size_t OFF_GS = al256(OFF_UG + (size_t)(32 * 1056 + 64) * 512 * 2);
constexpr size_t OFF_GM = al256(OFF_GS + (size_t)NTOK * 512 * 2);
constexpr size_t OFF_CQ = al256(OFF_GM + (size_t)NTOK * 512 * 2);
constexpr size_t OFF_SSQQ = al256(OFF_CQ + (size_t)NTOK * 256 * 2);
constexpr size_t OFF_CKVB = al256(OFF_SSQQ + (size_t)NTOK * 2 * 4);
constexpr size_t OFF_KRB = al256(OFF_CKVB + (size_t)NKV * 128 * 2);
constexpr size_t OFF_QB = al256(OFF_KRB + (size_t)NKV * 32 * 2);
constexpr size_t OFF_KFP = al256(OFF_QB + (size_t)NTOK * 768 * 2);
constexpr size_t OFF_KFS = al256(OFF_KFP + (size_t)16 * 8 * 2048 * 96 * 2);
constexpr size_t OFF_VTP = al256(OFF_KFS + (size_t)32 * 8 * 1056 * 96 * 2);
constexpr size_t OFF_VTS = al256(OFF_VTP + (size_t)16 * 8 * 64 * 2048 * 2);
constexpr size_t OFF_SSQ1 = al256(OFF_VTS + (size_t)32 * 8 * 64 * 1056 * 2);
constexpr size_t OFF_SSQ2 = al256(OFF_SSQ1 + (size_t)NTOK * 4 * 4);
constexpr size_t OFF_RSTD = al256(OFF_SSQ2 + (size_t)NTOK * 8 * 4);
constexpr size_t OFF_BAR = al256(OFF_RSTD + (size_t)NTOK * 4);
constexpr size_t BAR_BYTES = 64 * 256;
constexpr size_t WS_END = al256(OFF_BAR + BAR_BYTES);

constexpr int LDS_BYTES = 74752 + 16;
constexpr int TSTR = 72;
constexpr int TILE_E = 128 * TSTR;
constexpr int CSTR = 129;

struct Params {
  const float* in[29];
  float* out;
  unsigned char* ws;
};

typedef __attribute__((ext_vector_type(2))) float f32x2;
typedef __attribute__((ext_vector_type(2))) __bf16 bf16x2_t;
__device__ __forceinline__ unsigned pack2bf(float a, float b) {
  f32x2 v = {a, b};
  bf16x2_t r = __builtin_convertvector(v, bf16x2_t);
  return *(unsigned*)&r;
}
__device__ __forceinline__ bfu f2bf(float f) { return (bfu)(pack2bf(f, 0.f) & 0xffffu); }
__device__ __forceinline__ float bf2f(bfu b) { return __uint_as_float(((unsigned)b) << 16); }
__device__ __forceinline__ float wave_sum(float v) {
#pragma unroll
  for (int o = 32; o; o >>= 1) v += __shfl_xor(v, o);
  return v;
}
__device__ __forceinline__ float half_sum(float v) {
#pragma unroll
  for (int o = 16; o; o >>= 1) v += __shfl_xor(v, o);
  return v;
}
__device__ __forceinline__ float fexp(float x) { return __builtin_amdgcn_exp2f(x * 1.4426950408889634f); }
__device__ __forceinline__ float silu_f(float x) { return x * __builtin_amdgcn_rcpf(1.f + fexp(-x)); }
__device__ __forceinline__ float sigmoid_f(float x) { return __builtin_amdgcn_rcpf(1.f + fexp(-x)); }
__device__ __forceinline__ float gelu_f(float x) {
  float z = 0.7978845608028654f * (x + 0.044715f * x * x * x);
  float th = 1.f - 2.f * __builtin_amdgcn_rcpf(fexp(2.f * z) + 1.f);
  return 0.5f * x * (1.f + th);
}
typedef __attribute__((ext_vector_type(4))) unsigned u32x4v;
#define MFMA16(a, b, c) __builtin_amdgcn_mfma_f32_16x16x32_bf16((a), (b), (c), 0, 0, 0)
#define MFMA32(a, b, c) __builtin_amdgcn_mfma_f32_32x32x16_bf16((a), (b), (c), 0, 0, 0)

enum { MODE_ID = 0, MODE_WIN = 1, MODE_WUQ = 2 };
template <int MODE> __device__ __forceinline__ int colmap(int n) {
  if (MODE == MODE_WIN) {
    if (n < 1408) return n;
    if (n < 1920) return 1440 + (n - 1408);
    if (n < 1952) return 1408 + (n - 1920);
    return -1;
  } else if (MODE == MODE_WUQ) {
    if (n < 512) return (n >> 6) * 96 + (n & 63);
    int m = n - 512;
    return (m >> 5) * 96 + 64 + (m & 31);
  }
  return n;
}
template <int MODE>
__device__ void prep_wT(bfu* dst, const float* src, const float* gain, const float* gain2, int ksplit,
                        int Npad, int K, int ldsrc, long gtid, long gsz) {
  const long total = (long)Npad * (K >> 3);
  for (long idx = gtid; idx < total; idx += gsz) {
    const int kbl = (int)(idx & 7);
    const long i2 = idx >> 3;
    int n = (int)(i2 % Npad), kb = (int)(i2 / Npad) * 8 + kbl;
    int sc = colmap<MODE>(n);
    bf16x8 o;
#pragma unroll
    for (int j = 0; j < 8; ++j) {
      int k = kb * 8 + j;
      float v = 0.f;
      if (sc >= 0) {
        v = src[(long)k * ldsrc + sc];
        if (gain) v *= (k < ksplit) ? gain[k] : gain2[k - ksplit];
      }
      o[j] = (short)f2bf(v);
    }
    *(bf16x8*)(dst + (long)n * K + kb * 8) = o;
  }
}
__device__ __forceinline__ void ssm_xy(const Params& p, int g, int pp, float& x, float& y) {
  float dt = expf(p.in[10][g]);
  x = p.in[8][g * 64 + pp] * dt;
  y = p.in[9][g * 64 + pp] * dt;
}
__device__ __forceinline__ float2 cpowk(float x, float y, float k) {
  float e = expf(k * x), s, c;
  sincosf(k * y, &s, &c);
  return make_float2(e * c, e * s);
}
__device__ __forceinline__ float2 ssm_coef(const Params& p, int g, int pp, float x, float y) {
  float lr = p.in[8][g * 64 + pp], li = p.in[9][g * 64 + pp];
  float s, c;
  sincosf(y, &s, &c);
  float sh = sinf(0.5f * y);
  float ar = expm1f(x) * c - 2.f * sh * sh, ai = expf(x) * s;
  float d = 1.f / (lr * lr + li * li);
  return make_float2((ar * lr + ai * li) * d, (ai * lr - ar * li) * d);
}
__device__ __forceinline__ float2 cmul(float2 a, float2 b) { return make_float2(a.x * b.x - a.y * b.y, a.x * b.y + a.y * b.x); }

__device__ void phase0(const Params& p, unsigned char* smem) {
  const int tid = threadIdx.x, lane = tid & 63, wave = tid >> 6;
  const long gtid = (long)blockIdx.x * 256 + tid, gsz = (long)gridDim.x * 256;
  unsigned char* ws = p.ws;
  {
    float* rstd = (float*)(ws + OFF_RSTD);
    const int lane = tid & 63, wave = tid >> 6;
    for (int grp = blockIdx.x; grp < NTOK / 64; grp += gridDim.x) {
      for (int sub0 = 0; sub0 < 16; sub0 += 4) {
        float4 v[4][4];
#pragma unroll
        for (int u = 0; u < 4; ++u) {
          const int row = grp * 64 + (sub0 + u) * 4 + wave;
          const float* x = row < NP ? p.in[0] + (long)row * 1024 : p.in[1] + (long)(row - NP) * 1024;
#pragma unroll
          for (int i = 0; i < 4; ++i) v[u][i] = ((const float4*)x)[lane + 64 * i];
        }
#pragma unroll
        for (int u = 0; u < 4; ++u) {
          const int row = grp * 64 + (sub0 + u) * 4 + wave;
          bfu* xb = (bfu*)(ws + OFF_XB) + (long)row * 1024;
          float ss = 0.f;
#pragma unroll
          for (int i = 0; i < 4; ++i) {
            ss += v[u][i].x * v[u][i].x + v[u][i].y * v[u][i].y + v[u][i].z * v[u][i].z + v[u][i].w * v[u][i].w;
            ((uint2*)xb)[lane + 64 * i] = make_uint2(pack2bf(v[u][i].x, v[u][i].y), pack2bf(v[u][i].z, v[u][i].w));
          }
          ss = wave_sum(ss);
          if (lane == 0) rstd[row] = rsqrtf(ss * (1.f / 1024.f) + EPS);
        }
      }
    }
  }
  prep_wT<MODE_WIN>((bfu*)(ws + OFF_WIN), p.in[7], p.in[6], p.in[6], 1 << 30, 2048, 1024, 1952, gtid, gsz);
  prep_wT<MODE_WUQ>((bfu*)(ws + OFF_WUQ), p.in[20], p.in[18], p.in[18], 1 << 30, 768, 256, 768, gtid, gsz);
  prep_wT<MODE_ID>((bfu*)(ws + OFF_WUKV), p.in[21], nullptr, nullptr, 0, 1024, 128, 1024, gtid, gsz);
  prep_wT<MODE_ID>((bfu*)(ws + OFF_WGLU), p.in[16], nullptr, nullptr, 0, 512, 512, 512, gtid, gsz);
  prep_wT<MODE_ID>((bfu*)(ws + OFF_WOUT), p.in[28], p.in[26], p.in[27], 512, 1024, 1024, 1024, gtid, gsz);
  {
    bfu* ckvb = (bfu*)(ws + OFF_CKVB);
    for (long idx = gtid; idx < 32L * 1024 * 16; idx += gsz) {
      int c8 = (int)(idx & 15), t = (int)((idx >> 4) & 1023), b = (int)(idx >> 14);
      const float* s = p.in[2] + ((long)(b * 1024 + t) * 128 + c8 * 8);
      bf16x8 o;
#pragma unroll
      for (int j = 0; j < 8; ++j) o[j] = (short)f2bf(s[j]);
      *(bf16x8*)(ckvb + ((long)(NP + b * 1056 + t) * 128 + c8 * 8)) = o;
    }
    bfu* krb = (bfu*)(ws + OFF_KRB);
    for (long idx = gtid; idx < 32L * 1024 * 4; idx += gsz) {
      int c8 = (int)(idx & 3), t = (int)((idx >> 2) & 1023), b = (int)(idx >> 12);
      const float* s = p.in[3] + ((long)(b * 1024 + t) * 32 + c8 * 8);
      bf16x8 o;
#pragma unroll
      for (int j = 0; j < 8; ++j) o[j] = (short)f2bf(s[j]);
      *(bf16x8*)(krb + ((long)(NP + b * 1056 + t) * 32 + c8 * 8)) = o;
    }
  }
  {
    bfu* mt = (bfu*)(ws + OFF_MT);
    for (long idx = gtid; idx < 32L * 128 * 32; idx += gsz) {
      int s = (int)(idx & 31), n = (int)((idx >> 5) & 127), g = (int)(idx >> 12);
      int pp = n & 63;
      float x, y;
      ssm_xy(p, g, pp, x, y);
      float2 w = cmul(cpowk(x, y, (float)(31 - s)), ssm_coef(p, g, pp, x, y));
      bf16x8 o0, o1;
#pragma unroll
      for (int c = 0; c < 16; ++c) {
        float br = p.in[11][(g * 64 + pp) * 16 + c], bi = p.in[12][(g * 64 + pp) * 16 + c];
        float v = (n < 64) ? (w.x * br - w.y * bi) : (w.x * bi + w.y * br);
        if (c < 8) o0[c] = (short)f2bf(v); else o1[c - 8] = (short)f2bf(v);
      }
      bfu* d = mt + ((long)(g * 128 + n) * 512 + s * 16);
      *(bf16x8*)d = o0;
      *(bf16x8*)(d + 8) = o1;
    }
    bfu* et = (bfu*)(ws + OFF_ET);
    for (long idx = gtid; idx < 32L * 512 * 16; idx += gsz) {
      int kb = (int)(idx & 15), n = (int)((idx >> 4) & 511), g = (int)(idx >> 13);
      int t = n >> 4, cp = n & 15;
      unsigned long long w0 = 0ULL, w1 = 0ULL;
#pragma unroll 1
      for (int j = 0; j < 8; ++j) {
        int k = kb * 8 + j, pp = k & 63;
        float x, y;
        ssm_xy(p, g, pp, x, y);
        float2 a = cpowk(x, y, (float)(t + 1));
        float cr = p.in[13][(g * 16 + cp) * 64 + pp], ci = p.in[14][(g * 16 + cp) * 64 + pp];
        float v = (k < 64) ? (cr * a.x - ci * a.y) : -(cr * a.y + ci * a.x);
        const unsigned long long bb = (unsigned long long)f2bf(v);
        if (j < 4) w0 |= bb << (16 * j); else w1 |= bb << (16 * (j - 4));
      }
      *(uint4*)(et + ((long)(g * 512 + n) * 128 + kb * 8)) = make_uint4((unsigned)w0, (unsigned)(w0 >> 32), (unsigned)w1, (unsigned)(w1 >> 32));
    }
    float2* a32 = (float2*)(ws + OFF_A32);
    for (long idx = gtid; idx < 2048; idx += gsz) {
      int g = (int)(idx >> 6), pp = (int)(idx & 63);
      float x, y;
      ssm_xy(p, g, pp, x, y);
      a32[idx] = cpowk(x, y, 32.f);
    }
    bfu* ktab = (bfu*)(ws + OFF_KTAB);
    float* sW = (float*)smem;
    for (int it = blockIdx.x; it < 32 * 33; it += gridDim.x) {
      int g = it / 33, li = it % 33;
      if (tid < 64 && li > 0) {
        float x, y;
        ssm_xy(p, g, tid, x, y);
        float2 w = cmul(cpowk(x, y, (float)(li - 1)), ssm_coef(p, g, tid, x, y));
        sW[2 * tid] = w.x;
        sW[2 * tid + 1] = w.y;
      }
      __syncthreads();
      int cp = tid >> 4, c = tid & 15;
      float sum = 0.f;
      if (li > 0) {
        for (int pp = 0; pp < 64; ++pp) {
          float wr = sW[2 * pp], wi = sW[2 * pp + 1];
          float br = p.in[11][(g * 64 + pp) * 16 + c], bi = p.in[12][(g * 64 + pp) * 16 + c];
          float cr = p.in[13][(g * 16 + cp) * 64 + pp], ci = p.in[14][(g * 16 + cp) * 64 + pp];
          float wbr = wr * br - wi * bi, wbi = wr * bi + wi * br;
          sum += cr * wbr - ci * wbi;
        }
      }
      ktab[(long)(g * 33 + li) * 256 + cp * 16 + c] = f2bf(sum);
      __syncthreads();
    }
  }
}

struct GemmOp {
  const bfu* A;
  const bfu* A_hi;
  int lda, ksplit;
  const bfu* Bt;
  int ldb, K;
};

template <bool RESCALE>
__device__ __forceinline__ void gemm_tile(const GemmOp& g, int m0, int n0, unsigned char* smem, const float* sRatio) {
  const int tid = threadIdx.x, lane = tid & 63, wave = tid >> 6;
  const int wr = wave >> 1, wc = wave & 1, r = lane & 15, q = lane >> 4;
  bfu* sA0 = (bfu*)smem;
  bfu* sB0 = sA0 + TILE_E;
  bfu* sA1 = sB0 + TILE_E;
  bfu* sB1 = sA1 + TILE_E;
  f32x4 acc[4][4];
#pragma unroll
  for (int i = 0; i < 4; ++i)
#pragma unroll
    for (int j = 0; j < 4; ++j) acc[i][j] = (f32x4){0.f, 0.f, 0.f, 0.f};
  const int lrow = tid >> 3, lkc = (tid & 7) * 8;
  u32x4v ra0, ra1, ra2, ra3, rb0, rb1, rb2, rb3;
  const int nk = g.K >> 6;
  const unsigned offA = (unsigned)(lrow * g.lda + lkc), offB = (unsigned)(lrow * g.ldb + lkc);
  const unsigned stepA = (unsigned)(32 * g.lda), stepB = (unsigned)(32 * g.ldb);
  const bfu* Alo = g.A + (long)m0 * g.lda;
  const bfu* Ahi = g.A_hi + (long)m0 * g.lda - g.ksplit;
  const bfu* Bb = g.Bt + (long)n0 * g.ldb;
#define GLD8(Ab_, Bk_) do { \
    ra0 = *(const u32x4v*)((Ab_) + offA); ra1 = *(const u32x4v*)((Ab_) + (offA + stepA)); \
    ra2 = *(const u32x4v*)((Ab_) + (offA + 2 * stepA)); ra3 = *(const u32x4v*)((Ab_) + (offA + 3 * stepA)); \
    rb0 = *(const u32x4v*)((Bk_) + offB); rb1 = *(const u32x4v*)((Bk_) + (offB + stepB)); \
    rb2 = *(const u32x4v*)((Bk_) + (offB + 2 * stepB)); rb3 = *(const u32x4v*)((Bk_) + (offB + 3 * stepB)); } while (0)
#define LST8(dA_, dB_) do { \
    *(u32x4v*)((dA_) + lrow * TSTR + lkc) = ra0; *(u32x4v*)((dA_) + (lrow + 32) * TSTR + lkc) = ra1; \
    *(u32x4v*)((dA_) + (lrow + 64) * TSTR + lkc) = ra2; *(u32x4v*)((dA_) + (lrow + 96) * TSTR + lkc) = ra3; \
    *(u32x4v*)((dB_) + lrow * TSTR + lkc) = rb0; *(u32x4v*)((dB_) + (lrow + 32) * TSTR + lkc) = rb1; \
    *(u32x4v*)((dB_) + (lrow + 64) * TSTR + lkc) = rb2; *(u32x4v*)((dB_) + (lrow + 96) * TSTR + lkc) = rb3; } while (0)
  {
    const bfu* Ab = (0 < g.ksplit) ? Alo : Ahi;
    GLD8(Ab, Bb);
    LST8(sA0, sB0);
  }
  __syncthreads();
  for (int kt = 0; kt < nk; ++kt) {
    {
      const int k1 = ((kt + 1 < nk) ? (kt + 1) : kt) << 6;
      const bfu* Ab = ((k1 < g.ksplit) ? Alo : Ahi) + k1;
      const bfu* Bk = Bb + k1;
      GLD8(Ab, Bk);
    }
    asm volatile("" ::: "memory");
    __builtin_amdgcn_sched_barrier(0);
    const bfu* cA = (kt & 1) ? sA1 : sA0;
    const bfu* cB = (kt & 1) ? sB1 : sB0;
#pragma unroll
    for (int ks = 0; ks < 2; ++ks) {
      bf16x8 af[4], bfr[4];
#pragma unroll
      for (int i = 0; i < 4; ++i) {
        af[i] = *(const bf16x8*)(cA + (wr * 64 + i * 16 + r) * TSTR + ks * 32 + q * 8);
        bfr[i] = *(const bf16x8*)(cB + (wc * 64 + i * 16 + r) * TSTR + ks * 32 + q * 8);
      }
      __builtin_amdgcn_s_setprio(1);
#pragma unroll
      for (int i = 0; i < 4; ++i)
#pragma unroll
        for (int j = 0; j < 4; ++j) acc[i][j] = MFMA16(af[i], bfr[j], acc[i][j]);
      __builtin_amdgcn_s_setprio(0);
    }
    if (RESCALE) {
      if (((kt + 1) << 6) == g.ksplit) {
#pragma unroll
        for (int i = 0; i < 4; ++i)
#pragma unroll
          for (int e = 0; e < 4; ++e) {
            float sc = sRatio[wr * 64 + i * 16 + q * 4 + e];
#pragma unroll
            for (int j = 0; j < 4; ++j) acc[i][j][e] *= sc;
          }
      }
    }
    asm volatile("" ::: "memory");
    __builtin_amdgcn_sched_barrier(0);
    {
      bfu* nA = (kt & 1) ? sA0 : sA1;
      bfu* nB = (kt & 1) ? sB0 : sB1;
      LST8(nA, nB);
    }
    __syncthreads();
  }
  float* Cs = (float*)smem;
#pragma unroll
  for (int i = 0; i < 4; ++i)
#pragma unroll
    for (int j = 0; j < 4; ++j)
#pragma unroll
      for (int e = 0; e < 4; ++e) Cs[(wr * 64 + i * 16 + q * 4 + e) * CSTR + wc * 64 + j * 16 + r] = acc[i][j][e];
  __syncthreads();
}

__device__ __forceinline__ void gemm_tile_x(const float* __restrict__ X, const bfu* __restrict__ Bt, int n0,
                                            unsigned char* smem) {
  const int tid = threadIdx.x, lane = tid & 63, wave = tid >> 6;
  const int wr = wave >> 1, wc = wave & 1, r = lane & 15, q = lane >> 4;
  bfu* sA0 = (bfu*)smem;
  bfu* sB0 = sA0 + TILE_E;
  bfu* sA1 = sB0 + TILE_E;
  bfu* sB1 = sA1 + TILE_E;
  f32x4 acc[4][4];
#pragma unroll
  for (int i = 0; i < 4; ++i)
#pragma unroll
    for (int j = 0; j < 4; ++j) acc[i][j] = (f32x4){0.f, 0.f, 0.f, 0.f};
  const int arow = tid >> 4, af4 = (tid & 15) * 4;
  const int lrow = tid >> 3, lkc = (tid & 7) * 8;
  f32x4 xa0, xa1, xa2, xa3, xa4, xa5, xa6, xa7;
  u32x4v rb0, rb1, rb2, rb3;
  const unsigned offA = (unsigned)(arow * 1024 + af4), offB = (unsigned)(lrow * 1024 + lkc);
  const bfu* Bb = Bt + (long)n0 * 1024;
#define XCVT(dst, v) do { *(uint2*)(dst) = make_uint2(pack2bf((v).x, (v).y), pack2bf((v).z, (v).w)); } while (0)
#define XLD(Xk_, Bk_) do { \
    xa0 = *(const f32x4*)((Xk_) + offA); xa1 = *(const f32x4*)((Xk_) + (offA + 16384u)); \
    xa2 = *(const f32x4*)((Xk_) + (offA + 32768u)); xa3 = *(const f32x4*)((Xk_) + (offA + 49152u)); \
    xa4 = *(const f32x4*)((Xk_) + (offA + 65536u)); xa5 = *(const f32x4*)((Xk_) + (offA + 81920u)); \
    xa6 = *(const f32x4*)((Xk_) + (offA + 98304u)); xa7 = *(const f32x4*)((Xk_) + (offA + 114688u)); \
    rb0 = *(const u32x4v*)((Bk_) + offB); rb1 = *(const u32x4v*)((Bk_) + (offB + 32768u)); \
    rb2 = *(const u32x4v*)((Bk_) + (offB + 65536u)); rb3 = *(const u32x4v*)((Bk_) + (offB + 98304u)); } while (0)
#define XST(dA_, dB_) do { \
    XCVT((dA_) + arow * TSTR + af4, xa0); XCVT((dA_) + (arow + 16) * TSTR + af4, xa1); \
    XCVT((dA_) + (arow + 32) * TSTR + af4, xa2); XCVT((dA_) + (arow + 48) * TSTR + af4, xa3); \
    XCVT((dA_) + (arow + 64) * TSTR + af4, xa4); XCVT((dA_) + (arow + 80) * TSTR + af4, xa5); \
    XCVT((dA_) + (arow + 96) * TSTR + af4, xa6); XCVT((dA_) + (arow + 112) * TSTR + af4, xa7); \
    *(u32x4v*)((dB_) + lrow * TSTR + lkc) = rb0; *(u32x4v*)((dB_) + (lrow + 32) * TSTR + lkc) = rb1; \
    *(u32x4v*)((dB_) + (lrow + 64) * TSTR + lkc) = rb2; *(u32x4v*)((dB_) + (lrow + 96) * TSTR + lkc) = rb3; } while (0)
  XLD(X, Bb);
  XST(sA0, sB0);
  __syncthreads();
  for (int kt = 0; kt < 16; ++kt) {
    {
      const int k1 = ((kt + 1 < 16) ? (kt + 1) : kt) << 6;
      const float* Xk = X + k1;
      const bfu* Bk = Bb + k1;
      XLD(Xk, Bk);
    }
    asm volatile("" ::: "memory");
    __builtin_amdgcn_sched_barrier(0);
    const bfu* cA = (kt & 1) ? sA1 : sA0;
    const bfu* cB = (kt & 1) ? sB1 : sB0;
#pragma unroll
    for (int ks = 0; ks < 2; ++ks) {
      bf16x8 af[4], bfr[4];
#pragma unroll
      for (int i = 0; i < 4; ++i) {
        af[i] = *(const bf16x8*)(cA + (wr * 64 + i * 16 + r) * TSTR + ks * 32 + q * 8);
        bfr[i] = *(const bf16x8*)(cB + (wc * 64 + i * 16 + r) * TSTR + ks * 32 + q * 8);
      }
#pragma unroll
      for (int i = 0; i < 4; ++i)
#pragma unroll
        for (int j = 0; j < 4; ++j) acc[i][j] = MFMA16(af[i], bfr[j], acc[i][j]);
    }
    asm volatile("" ::: "memory");
    __builtin_amdgcn_sched_barrier(0);
    {
      bfu* nA = (kt & 1) ? sA0 : sA1;
      bfu* nB = (kt & 1) ? sB0 : sB1;
      XST(nA, nB);
    }
    __syncthreads();
  }
  float* Cs = (float*)smem;
#pragma unroll
  for (int i = 0; i < 4; ++i)
#pragma unroll
    for (int j = 0; j < 4; ++j)
#pragma unroll
      for (int e = 0; e < 4; ++e) Cs[(wr * 64 + i * 16 + q * 4 + e) * CSTR + wc * 64 + j * 16 + r] = acc[i][j][e];
  __syncthreads();
}

__device__ __forceinline__ void rope_sc(float pos, int i, float& sn, float& cs) {
  float inv = exp2f(-(float)i * 0.8304820237218406f);
  sincosf(pos * inv, &sn, &cs);
}

__device__ void epi_win(const Params& p, int m0, int n0, const float* Cs) {
  const int tid = threadIdx.x, lane = tid & 63, wave = tid >> 6;
  unsigned char* ws = p.ws;
  const int nt = n0 >> 7;
  const float rs_all = ((const float*)(ws + OFF_RSTD))[m0 + wave + 4 * (lane & 31)];
  for (int rr = wave; rr < 128; rr += 4) {
    const int row = m0 + rr;
    const float rs = __shfl(rs_all, rr >> 2);
    float v0 = Cs[rr * CSTR + lane] * rs, v1 = Cs[rr * CSTR + 64 + lane] * rs;
    const bool samp = row >= NP;
    int b, t;
    if (!samp) { b = row >> 11; t = row & 2047; } else { int q_ = row - NP; b = q_ >> 5; t = q_ & 31; }
    const long kvrow = samp ? (long)(NP + b * 1056 + 1024 + t) : (long)row;
    if (nt < 4) {
      bfu* ug = (bfu*)(ws + OFF_UG);
      const int R = samp ? 1024 + b : b * 64 + (t >> 5);
      const int s = samp ? t : (t & 31);
      const int c0 = n0 + lane, c1 = c0 + 64;
      ug[((long)((c0 >> 4) * 1056 + R) * 512) + s * 16 + (c0 & 15)] = f2bf(v0);
      ug[((long)((c1 >> 4) * 1056 + R) * 512) + s * 16 + (c1 & 15)] = f2bf(v1);
    } else if (nt < 8) {
      bfu* gs = (bfu*)(ws + OFF_GS);
      gs[(long)row * 512 + (n0 - 512) + lane] = f2bf(silu_f(v0));
      gs[(long)row * 512 + (n0 - 512) + 64 + lane] = f2bf(silu_f(v1));
    } else if (nt < 10) {
      bfu* cq = (bfu*)(ws + OFF_CQ);
      cq[(long)row * 256 + (n0 - 1024) + lane] = f2bf(v0);
      cq[(long)row * 256 + (n0 - 1024) + 64 + lane] = f2bf(v1);
      float ss = wave_sum(v0 * v0 + v1 * v1);
      if (lane == 0) ((float*)(ws + OFF_SSQQ))[(long)(nt - 8) * NTOK + row] = ss;
    } else if (nt == 10) {
      float ss = wave_sum(v0 * v0 + v1 * v1);
      float rn = rsqrtf(ss * (1.f / 128.f) + EPS);
      float y0 = v0 * rn * p.in[19][lane], y1 = v1 * rn * p.in[19][lane + 64];
      float* o = samp ? p.out + O_CKVS + (long)(row - NP) * 128 : p.out + O_CKVP + (long)row * 128;
      o[lane] = y0;
      o[lane + 64] = y1;
      bfu* ckvb = (bfu*)(ws + OFF_CKVB);
      ckvb[kvrow * 128 + lane] = f2bf(y0);
      ckvb[kvrow * 128 + 64 + lane] = f2bf(y1);
    } else if (nt < 15) {
      bfu* gm = (bfu*)(ws + OFF_GM);
      gm[(long)row * 512 + (n0 - 1408) + lane] = f2bf(silu_f(v0));
      gm[(long)row * 512 + (n0 - 1408) + 64 + lane] = f2bf(silu_f(v1));
    } else {
      float v = lane < 32 ? v0 : 0.f;
      float ss = wave_sum(v * v);
      float rn = rsqrtf(ss * (1.f / 32.f) + EPS);
      float y = v * rn * p.in[25][lane & 31];
      float pr = __shfl_xor(y, 16);
      float sn, cs;
      rope_sc(samp ? (float)(1024 + t) : (float)t, lane & 15, sn, cs);
      float o = (lane & 16) ? (pr * sn + y * cs) : (y * cs - pr * sn);
      if (lane < 32) {
        float* op = samp ? p.out + O_KRS + (long)(row - NP) * 32 : p.out + O_KRP + (long)row * 32;
        op[lane] = o;
        ((bfu*)(ws + OFF_KRB))[kvrow * 32 + lane] = f2bf(o);
      }
    }
  }
}

#define QSCALE 0.14724444618947659f

__device__ void epi_q(const Params& p, int m0, int n0, const float* Cs) {
  const int tid = threadIdx.x, lane = tid & 63, wave = tid >> 6;
  unsigned char* ws = p.ws;
  const int nt = n0 >> 7;
  const float* ssqq = (const float*)(ws + OFF_SSQQ);
  bfu* qb = (bfu*)(ws + OFF_QB);
  const float rq_all = rsqrtf((ssqq[m0 + wave + 4 * (lane & 31)] + ssqq[NTOK + m0 + wave + 4 * (lane & 31)]) * (1.f / 256.f) + EPS);
  for (int rr = wave; rr < 128; rr += 4) {
    const int row = m0 + rr;
    const float rq = __shfl(rq_all, rr >> 2);
    float v0 = Cs[rr * CSTR + lane] * rq, v1 = Cs[rr * CSTR + 64 + lane] * rq;
    if (nt < 4) {
      float s0 = wave_sum(v0 * v0), s1 = wave_sum(v1 * v1);
      float gq = p.in[22][lane] * QSCALE;
      float y0 = v0 * rsqrtf(s0 * (1.f / 64.f) + EPS) * gq;
      float y1 = v1 * rsqrtf(s1 * (1.f / 64.f) + EPS) * gq;
      qb[(long)row * 768 + (2 * nt) * 96 + lane] = f2bf(y0);
      qb[(long)row * 768 + (2 * nt + 1) * 96 + lane] = f2bf(y1);
    } else {
      const int hb = (nt - 4) * 4, d = lane & 31;
      float s0 = half_sum(v0 * v0), s1 = half_sum(v1 * v1);
      float gq = p.in[24][d];
      float y0 = v0 * rsqrtf(s0 * (1.f / 32.f) + EPS) * gq;
      float y1 = v1 * rsqrtf(s1 * (1.f / 32.f) + EPS) * gq;
      float p0 = __shfl_xor(y0, 16), p1 = __shfl_xor(y1, 16);
      float pos = row < NP ? (float)(row & 2047) : (float)(1024 + ((row - NP) & 31));
      float sn, cs;
      rope_sc(pos, lane & 15, sn, cs);
      float o0 = (lane & 16) ? (p0 * sn + y0 * cs) : (y0 * cs - p0 * sn);
      float o1 = (lane & 16) ? (p1 * sn + y1 * cs) : (y1 * cs - p1 * sn);
      qb[(long)row * 768 + (hb + (lane >> 5)) * 96 + 64 + d] = f2bf(o0 * QSCALE);
      qb[(long)row * 768 + (hb + 2 + (lane >> 5)) * 96 + 64 + d] = f2bf(o1 * QSCALE);
    }
  }
}

__device__ void epi_kv(const Params& p, int m0, int n0, const float* Cs) {
  const int tid = threadIdx.x, lane = tid & 63, wave = tid >> 6;
  unsigned char* ws = p.ws;
  const int h = n0 >> 7;
  const bfu* krb = (const bfu*)(ws + OFF_KRB);
  const float gkn = p.in[23][lane];
  for (int rr0 = wave; rr0 < 128; rr0 += 16) {
    bfu kr[4];
#pragma unroll
    for (int u = 0; u < 4; ++u) kr[u] = krb[(long)(m0 + rr0 + 4 * u) * 32 + (lane & 31)];
#pragma unroll
    for (int u = 0; u < 4; ++u) {
      const int rr = rr0 + 4 * u;
      const long kvrow = m0 + rr;
      bfu* kd;
      if (kvrow < NP) {
        int b = (int)(kvrow >> 11), t = (int)(kvrow & 2047);
        kd = (bfu*)(ws + OFF_KFP) + ((long)((b * 8 + h) * 2048 + t)) * 96;
      } else {
        int ks = (int)(kvrow - NP);
        int b = ks / 1056, tt = ks % 1056;
        kd = (bfu*)(ws + OFF_KFS) + ((long)((b * 8 + h) * 1056 + tt)) * 96;
      }
      float v0 = Cs[rr * CSTR + lane];
      float ss = wave_sum(v0 * v0);
      float y = v0 * rsqrtf(ss * (1.f / 64.f) + EPS) * gkn;
      kd[lane] = f2bf(y);
      if (lane < 32) kd[64 + lane] = kr[u];
    }
  }
  for (int vc = wave; vc < 64; vc += 4) {
#pragma unroll
    for (int hf = 0; hf < 2; ++hf) {
      const int rr = lane + 64 * hf;
      const long kvrow = m0 + rr;
      bfu* vd;
      if (kvrow < NP) {
        int b = (int)(kvrow >> 11), t = (int)(kvrow & 2047);
        vd = (bfu*)(ws + OFF_VTP) + ((long)((b * 8 + h) * 64 + vc)) * 2048 + t;
      } else {
        int ks = (int)(kvrow - NP);
        int b = ks / 1056, tt = ks % 1056;
        vd = (bfu*)(ws + OFF_VTS) + ((long)((b * 8 + h) * 64 + vc)) * 1056 + tt;
      }
      *vd = f2bf(Cs[rr * CSTR + 64 + vc]);
    }
  }
}

__device__ void epi_glu(const Params& p, int m0, int n0, const float* Cs) {
  const int tid = threadIdx.x, lane = tid & 63, wave = tid >> 6;
  unsigned char* ws = p.ws;
  const int nt = n0 >> 7;
  const bfu* yg = (const bfu*)(ws + OFF_YG);
  const bfu* gs = (const bfu*)(ws + OFF_GS);
  bfu* a1 = (bfu*)(ws + OFF_A1);
  const int c0 = n0 + lane, c1 = c0 + 64;
  const float bg0 = p.in[17][c0], bg1 = p.in[17][c1];
  for (int rr0 = wave; rr0 < 128; rr0 += 16) {
    bfu y0[4], y1[4], g0[4], g1[4];
#pragma unroll
    for (int u = 0; u < 4; ++u) {
      const long row = m0 + rr0 + 4 * u;
      y0[u] = yg[row * 512 + c0]; y1[u] = yg[row * 512 + c1];
      g0[u] = gs[row * 512 + c0]; g1[u] = gs[row * 512 + c1];
    }
#pragma unroll
    for (int u = 0; u < 4; ++u) {
      const int rr = rr0 + 4 * u;
      const long row = m0 + rr;
      float z0 = Cs[rr * CSTR + lane] + bg0, z1 = Cs[rr * CSTR + 64 + lane] + bg1;
      float o0 = bf2f(y0[u]) * sigmoid_f(z0);
      float o1 = bf2f(y1[u]) * sigmoid_f(z1);
      float ss = wave_sum(o0 * o0 + o1 * o1);
      if (lane == 0) ((float*)(ws + OFF_SSQ1))[(long)nt * NTOK + row] = ss;
      a1[row * 512 + c0] = f2bf(o0 * bf2f(g0[u]));
      a1[row * 512 + c1] = f2bf(o1 * bf2f(g1[u]));
    }
  }
}

__device__ void epi_out(const Params& p, int m0, int n0, const float* Cs, const float* sR2) {
  const int tid = threadIdx.x, lane = tid & 63, wave = tid >> 6;
  for (int rr0 = wave; rr0 < 128; rr0 += 16) {
    float x0[4], x1[4];
#pragma unroll
    for (int u = 0; u < 4; ++u) {
      const int row = m0 + rr0 + 4 * u;
      const float* x = row < NP ? p.in[0] + (long)row * 1024 : p.in[1] + (long)(row - NP) * 1024;
      x0[u] = x[n0 + lane]; x1[u] = x[n0 + 64 + lane];
    }
#pragma unroll
    for (int u = 0; u < 4; ++u) {
      const int rr = rr0 + 4 * u;
      const int row = m0 + rr;
      const float r2 = sR2[rr];
      float* o = row < NP ? p.out + O_YP + (long)row * 1024 : p.out + O_YS + (long)(row - NP) * 1024;
      o[n0 + lane] = x0[u] + r2 * Cs[rr * CSTR + lane];
      o[n0 + 64 + lane] = x1[u] + r2 * Cs[rr * CSTR + 64 + lane];
    }
  }
}

struct AttnState {
  f32x16 o0, o1;
  float m, l;
};

__device__ __forceinline__ void attn_step(AttnState& st, const bf16x8 (&qf)[6], const bf16x8 (&kf)[6], const bf16x8 (&vf)[2][2]) {
  f32x16 s;
#pragma unroll
  for (int i = 0; i < 16; ++i) s[i] = 0.f;
  __builtin_amdgcn_s_setprio(1);
#pragma unroll
  for (int k = 0; k < 6; ++k) s = MFMA32(kf[k], qf[k], s);
  __builtin_amdgcn_s_setprio(0);
  float mx = s[0];
#pragma unroll
  for (int i = 1; i < 16; ++i) mx = fmaxf(mx, s[i]);
  mx = fmaxf(mx, __shfl_xor(mx, 32));
  const float mn = fmaxf(st.m, mx);
  const float alpha = __builtin_amdgcn_exp2f(st.m - mn);
  st.m = mn;
  float ls = 0.f;
  u32x4v pw0, pw1;
#pragma unroll
  for (int i = 0; i < 16; i += 2) {
    float e0 = __builtin_amdgcn_exp2f(s[i] - mn), e1 = __builtin_amdgcn_exp2f(s[i + 1] - mn);
    ls += e0 + e1;
    const unsigned w = pack2bf(e0, e1);
    if (i < 8) pw0[i >> 1] = w; else pw1[(i - 8) >> 1] = w;
  }
  const bf16x8 pb0 = *(bf16x8*)&pw0, pb1 = *(bf16x8*)&pw1;
  st.l = st.l * alpha + ls;
#pragma unroll
  for (int i = 0; i < 16; ++i) { st.o0[i] *= alpha; st.o1[i] *= alpha; }
  __builtin_amdgcn_s_setprio(1);
  st.o0 = MFMA32(vf[0][0], pb0, st.o0);
  st.o0 = MFMA32(vf[0][1], pb1, st.o0);
  st.o1 = MFMA32(vf[1][0], pb0, st.o1);
  st.o1 = MFMA32(vf[1][1], pb1, st.o1);
  __builtin_amdgcn_s_setprio(0);
}

__device__ __forceinline__ void attn_finish(const Params& p, AttnState& st, float ltot, long token, int h, int lane) {
  unsigned char* ws = p.ws;
  const int hh = lane >> 5;
  const float inv = __builtin_amdgcn_rcpf(ltot);
  float ss = 0.f;
#pragma unroll
  for (int i = 0; i < 16; ++i) {
    st.o0[i] *= inv; st.o1[i] *= inv;
    ss += st.o0[i] * st.o0[i] + st.o1[i] * st.o1[i];
  }
  ss += __shfl_xor(ss, 32);
  if (hh == 0) ((float*)(ws + OFF_SSQ2))[(long)h * NTOK + token] = ss;
  const bfu* gm = (const bfu*)(ws + OFF_GM) + token * 512 + h * 64;
  bfu* a2 = (bfu*)(ws + OFF_A2) + token * 512 + h * 64;
#pragma unroll
  for (int mt = 0; mt < 2; ++mt)
#pragma unroll
    for (int g4 = 0; g4 < 4; ++g4) {
      const int v0 = 32 * mt + 8 * g4 + 4 * hh;
      ushort4 gt = *(const ushort4*)(gm + v0);
      ushort4 o;
      float a = mt ? st.o1[4 * g4 + 0] : st.o0[4 * g4 + 0];
      float b = mt ? st.o1[4 * g4 + 1] : st.o0[4 * g4 + 1];
      float c = mt ? st.o1[4 * g4 + 2] : st.o0[4 * g4 + 2];
      float d = mt ? st.o1[4 * g4 + 3] : st.o0[4 * g4 + 3];
      o.x = f2bf(a * bf2f(gt.x)); o.y = f2bf(b * bf2f(gt.y)); o.z = f2bf(c * bf2f(gt.z)); o.w = f2bf(d * bf2f(gt.w));
      *(ushort4*)(a2 + v0) = o;
    }
}

constexpr int KSTR = 104;
constexpr int VSTR = 68;

__device__ void attn_prompt_item(const Params& p, int bh, int j, unsigned char* smem) {
  const int tid = threadIdx.x, lane = tid & 63, wave = tid >> 6;
  const int r32 = lane & 31, hh = lane >> 5;
  unsigned char* ws = p.ws;
  const int b = bh >> 3, h = bh & 7;
  const long tok = (long)b * 2048 + j * 128 + wave * 32 + r32;
  const bfu* qp = (const bfu*)(ws + OFF_QB) + tok * 768 + h * 96;
  bf16x8 qf[6];
#pragma unroll
  for (int k = 0; k < 6; ++k) qf[k] = *(const bf16x8*)(qp + 16 * k + 8 * hh);
  const bfu* Kb = (const bfu*)(ws + OFF_KFP) + (long)bh * 2048 * 96;
  const bfu* Vb = (const bfu*)(ws + OFF_VTP) + (long)bh * 64 * 2048;
  bfu* sK = (bfu*)smem;
  bfu* sV = (bfu*)(smem + 2 * 64 * KSTR * 2);
  const int nkt = 2 * j + 2;
  const int my_nkt = 2 * j + (wave >> 1) + 1;
  AttnState st;
#pragma unroll
  for (int i = 0; i < 16; ++i) { st.o0[i] = 0.f; st.o1[i] = 0.f; }
  st.m = -1e30f; st.l = 0.f;
  u32x4v rk0, rk1, rk2, rv0, rv1;
  int krow[3], kcc[3];
#pragma unroll
  for (int i = 0; i < 3; ++i) { int c = tid + i * 256; krow[i] = c / 12; kcc[i] = c % 12; }
  const int vrow0 = tid >> 3, vcc = tid & 7;
  const unsigned ko0 = (unsigned)(krow[0] * 96 + kcc[0] * 8), ko1 = (unsigned)(krow[1] * 96 + kcc[1] * 8), ko2 = (unsigned)(krow[2] * 96 + kcc[2] * 8);
  const unsigned vo0 = (unsigned)(vrow0 * 2048 + vcc * 8), vo1 = vo0 + 32u * 2048u;
  const int kl0 = krow[0] * KSTR + kcc[0] * 8, kl1 = krow[1] * KSTR + kcc[1] * 8, kl2 = krow[2] * KSTR + kcc[2] * 8;
  const int vl0 = vrow0 * VSTR + vcc * 8, vl1 = (vrow0 + 32) * VSTR + vcc * 8;
#define VST(base, off, v) do { bfu* d_ = (base) + (off); *(uint2*)d_ = make_uint2((v).x, (v).y); *(uint2*)(d_ + 4) = make_uint2((v).z, (v).w); } while (0)
  rk0 = *(const u32x4v*)(Kb + ko0); rk1 = *(const u32x4v*)(Kb + ko1); rk2 = *(const u32x4v*)(Kb + ko2);
  rv0 = *(const u32x4v*)(Vb + vo0); rv1 = *(const u32x4v*)(Vb + vo1);
  *(u32x4v*)(sK + kl0) = rk0; *(u32x4v*)(sK + kl1) = rk1; *(u32x4v*)(sK + kl2) = rk2;
  VST(sV, vl0, rv0); VST(sV, vl1, rv1);
  __syncthreads();
  for (int kt = 0; kt < nkt; ++kt) {
    {
      const int kn = (kt + 1 < nkt) ? (kt + 1) : kt;
      const bfu* Kn = Kb + kn * 6144;
      const bfu* Vn = Vb + kn * 64;
      rk0 = *(const u32x4v*)(Kn + ko0); rk1 = *(const u32x4v*)(Kn + ko1); rk2 = *(const u32x4v*)(Kn + ko2);
      rv0 = *(const u32x4v*)(Vn + vo0); rv1 = *(const u32x4v*)(Vn + vo1);
    }
    asm volatile("" ::: "memory");
    __builtin_amdgcn_sched_barrier(0);
    if (kt < my_nkt) {
      const bfu* cK = sK + (kt & 1) * 64 * KSTR;
      const bfu* cV = sV + (kt & 1) * 64 * VSTR;
#pragma unroll
      for (int sub = 0; sub < 2; ++sub) {
        bf16x8 kf[6], vf[2][2];
#pragma unroll
        for (int k = 0; k < 6; ++k) kf[k] = *(const bf16x8*)(cK + (sub * 32 + r32) * KSTR + 16 * k + 8 * hh);
#pragma unroll
        for (int mt = 0; mt < 2; ++mt)
#pragma unroll
          for (int s2 = 0; s2 < 2; ++s2) {
            const bfu* vp = cV + (mt * 32 + r32) * VSTR + sub * 32 + 16 * s2 + 4 * hh;
            uint2 lo = *(const uint2*)vp, hi = *(const uint2*)(vp + 8);
            uint4 w = make_uint4(lo.x, lo.y, hi.x, hi.y);
            vf[mt][s2] = *(bf16x8*)&w;
          }
        attn_step(st, qf, kf, vf);
      }
    }
    asm volatile("" ::: "memory");
    __builtin_amdgcn_sched_barrier(0);
    {
      bfu* nK = sK + ((kt + 1) & 1) * 64 * KSTR;
      bfu* nV = sV + ((kt + 1) & 1) * 64 * VSTR;
      *(u32x4v*)(nK + kl0) = rk0; *(u32x4v*)(nK + kl1) = rk1; *(u32x4v*)(nK + kl2) = rk2;
      VST(nV, vl0, rv0); VST(nV, vl1, rv1);
    }
    __syncthreads();
  }
  attn_finish(p, st, st.l + __shfl_xor(st.l, 32), tok, h, lane);
}

__device__ void attn_sample_item(const Params& p, int bh, unsigned char* smem) {
  const int tid = threadIdx.x, lane = tid & 63, wave = tid >> 6;
  const int r32 = lane & 31, hh = lane >> 5;
  unsigned char* ws = p.ws;
  const int b = bh >> 3, h = bh & 7;
  const long tok = (long)NP + b * 32 + r32;
  const bfu* qp = (const bfu*)(ws + OFF_QB) + tok * 768 + h * 96;
  bf16x8 qf[6];
#pragma unroll
  for (int k = 0; k < 6; ++k) qf[k] = *(const bf16x8*)(qp + 16 * k + 8 * hh);
  const bfu* Kb = (const bfu*)(ws + OFF_KFS) + (long)bh * 1056 * 96;
  const bfu* Vb = (const bfu*)(ws + OFF_VTS) + (long)bh * 64 * 1056;
  float* sO = (float*)smem;
  float* sM = sO + 4 * 32 * 64;
  float* sL = sM + 128;
  AttnState st;
#pragma unroll
  for (int i = 0; i < 16; ++i) { st.o0[i] = 0.f; st.o1[i] = 0.f; }
  st.m = -1e30f; st.l = 0.f;
#pragma unroll 1
  for (int su = wave; su < 33; su += 4) {
    bf16x8 kf[6], vf[2][2];
#pragma unroll
    for (int k = 0; k < 6; ++k) kf[k] = *(const bf16x8*)(Kb + (long)(su * 32 + r32) * 96 + 16 * k + 8 * hh);
#pragma unroll
    for (int mt = 0; mt < 2; ++mt)
#pragma unroll
      for (int s2 = 0; s2 < 2; ++s2) {
        const bfu* vp = Vb + (long)(mt * 32 + r32) * 1056 + su * 32 + 16 * s2 + 4 * hh;
        uint2 lo = *(const uint2*)vp, hi = *(const uint2*)(vp + 8);
        uint4 w = make_uint4(lo.x, lo.y, hi.x, hi.y);
        vf[mt][s2] = *(bf16x8*)&w;
      }
    attn_step(st, qf, kf, vf);
  }
  float l = st.l + __shfl_xor(st.l, 32);
  if (wave > 0) {
#pragma unroll
    for (int i = 0; i < 16; ++i) {
      sO[(wave * 32 + i) * 64 + lane] = st.o0[i];
      sO[(wave * 32 + 16 + i) * 64 + lane] = st.o1[i];
    }
    if (hh == 0) { sM[wave * 32 + r32] = st.m; sL[wave * 32 + r32] = l; }
  }
  __syncthreads();
  if (wave == 0) {
    float M = st.m;
#pragma unroll
    for (int w = 1; w < 4; ++w) M = fmaxf(M, sM[w * 32 + r32]);
    const float f0 = exp2f(st.m - M);
    float L = l * f0;
#pragma unroll
    for (int i = 0; i < 16; ++i) { st.o0[i] *= f0; st.o1[i] *= f0; }
#pragma unroll
    for (int w = 1; w < 4; ++w) {
      const float fw = exp2f(sM[w * 32 + r32] - M);
      L += fw * sL[w * 32 + r32];
#pragma unroll
      for (int i = 0; i < 16; ++i) {
        st.o0[i] += fw * sO[(w * 32 + i) * 64 + lane];
        st.o1[i] += fw * sO[(w * 32 + 16 + i) * 64 + lane];
      }
    }
    attn_finish(p, st, L, tok, h, lane);
  }
  __syncthreads();
}

__device__ void ssm_item(const Params& p, int g, int b, bool samp, unsigned char* smem, int jh_lo, int jh_hi) {
  const int tid = threadIdx.x, lane = tid & 63, wave = tid >> 6;
  const int r = lane & 15, q = lane >> 4;
  unsigned char* ws = p.ws;
  float* sS = (float*)smem;
  bfu* sH = (bfu*)(smem + 32768);
  bfu* sK = (bfu*)(smem + 32768 + 17408);
  const int R0 = samp ? 1024 : b * 64;
  const bfu* Ug = (const bfu*)(ws + OFF_UG) + ((long)(g * 1056 + R0)) * 512;
  const bfu* MT = (const bfu*)(ws + OFF_MT) + (long)g * 128 * 512;
  const bfu* ET = (const bfu*)(ws + OFF_ET) + (long)g * 512 * 128;
  {
    const uint4* src = (const uint4*)((const bfu*)(ws + OFF_KTAB) + (long)g * 33 * 256);
    for (int c = tid; c < 1056; c += 256) ((uint4*)sK)[c] = src[c];
  }
  {
    f32x4 acc[4][2];
#pragma unroll
    for (int i = 0; i < 4; ++i) { acc[i][0] = (f32x4){0.f, 0.f, 0.f, 0.f}; acc[i][1] = acc[i][0]; }
    for (int ks = 0; ks < 16; ++ks) {
      bf16x8 af[4], bfr[2];
#pragma unroll
      for (int i = 0; i < 4; ++i) af[i] = *(const bf16x8*)(Ug + (long)(i * 16 + r) * 512 + ks * 32 + q * 8);
#pragma unroll
      for (int j = 0; j < 2; ++j) bfr[j] = *(const bf16x8*)(MT + (long)(wave * 32 + j * 16 + r) * 512 + ks * 32 + q * 8);
#pragma unroll
      for (int i = 0; i < 4; ++i)
#pragma unroll
        for (int j = 0; j < 2; ++j) acc[i][j] = MFMA16(af[i], bfr[j], acc[i][j]);
    }
#pragma unroll
    for (int i = 0; i < 4; ++i)
#pragma unroll
      for (int j = 0; j < 2; ++j)
#pragma unroll
        for (int e = 0; e < 4; ++e) sS[(i * 16 + q * 4 + e) * 128 + wave * 32 + j * 16 + r] = acc[i][j][e];
  }
  __syncthreads();
  {
    const float2* a32 = (const float2*)(ws + OFF_A32) + g * 64;
    if (!samp) {
      if (tid < 64) {
        const float2 a = a32[tid];
        float hr = 0.f, hi = 0.f;
        for (int c = 0; c < 64; ++c) {
          sH[c * 136 + tid] = f2bf(hr);
          sH[c * 136 + 64 + tid] = f2bf(hi);
          float sr = sS[c * 128 + tid], si = sS[c * 128 + 64 + tid];
          float nr = a.x * hr - a.y * hi + sr, ni = a.x * hi + a.y * hr + si;
          hr = nr; hi = ni;
        }
        p.out[O_REP + (long)(b * 32 + g) * 64 + tid] = hr;
        p.out[O_IMP + (long)(b * 32 + g) * 64 + tid] = hi;
      }
    } else {
      for (int idx = tid; idx < 32 * 64; idx += 256) {
        const int bb = idx >> 6, pp = idx & 63;
        const float2 a = a32[pp];
        float hr = p.in[4][(long)(bb * 32 + g) * 64 + pp], hi = p.in[5][(long)(bb * 32 + g) * 64 + pp];
        sH[bb * 136 + pp] = f2bf(hr);
        sH[bb * 136 + 64 + pp] = f2bf(hi);
        float sr = sS[bb * 128 + pp], si = sS[bb * 128 + 64 + pp];
        p.out[O_RES + (long)(bb * 32 + g) * 64 + pp] = a.x * hr - a.y * hi + sr;
        p.out[O_IMS + (long)(bb * 32 + g) * 64 + pp] = a.x * hi + a.y * hr + si;
      }
      for (int idx = tid; idx < 32 * 128; idx += 256) sH[(32 + (idx >> 7)) * 136 + (idx & 127)] = 0;
    }
  }
  __syncthreads();
  {
    const float dd = p.in[15][g * 16 + r];
    bfu* yg = (bfu*)(ws + OFF_YG);
    const int nrows = samp ? 32 : 64;
#pragma unroll 1
    for (int jh = jh_lo; jh < jh_hi; ++jh) {
      f32x4 acc[4][4];
#pragma unroll
      for (int i = 0; i < 4; ++i)
#pragma unroll
        for (int j = 0; j < 4; ++j) acc[i][j] = (f32x4){0.f, 0.f, 0.f, 0.f};
      const int tb = wave + 16 * jh;
      const int tmax = tb + 12;
#pragma unroll 1
      for (int ks = 0; ks < 16; ++ks) {
        const int s0 = 2 * ks;
        if (s0 > tmax) break;
        bf16x8 af[4];
#pragma unroll
        for (int i = 0; i < 4; ++i) af[i] = *(const bf16x8*)(Ug + (long)(i * 16 + r) * 512 + ks * 32 + q * 8);
#pragma unroll
        for (int j = 0; j < 4; ++j) {
          const int t = tb + 4 * j;
          if (t >= s0) {
            const int li = t - s0 - (q >> 1) + 1;
            bf16x8 bfr = *(const bf16x8*)(sK + li * 256 + r * 16 + (q & 1) * 8);
#pragma unroll
            for (int i = 0; i < 4; ++i) acc[i][j] = MFMA16(af[i], bfr, acc[i][j]);
          }
        }
      }
#pragma unroll 1
      for (int kc = 0; kc < 4; ++kc) {
        bf16x8 af[4];
#pragma unroll
        for (int i = 0; i < 4; ++i) af[i] = *(const bf16x8*)(sH + (i * 16 + r) * 136 + kc * 32 + q * 8);
#pragma unroll
        for (int j = 0; j < 4; ++j) {
          const int t = tb + 4 * j;
          bf16x8 bfr = *(const bf16x8*)(ET + (long)(t * 16 + r) * 128 + kc * 32 + q * 8);
#pragma unroll
          for (int i = 0; i < 4; ++i) acc[i][j] = MFMA16(af[i], bfr, acc[i][j]);
        }
      }
#pragma unroll
      for (int i = 0; i < 4; ++i) {
        bfu uu[4][4];
#pragma unroll
        for (int j = 0; j < 4; ++j)
#pragma unroll
          for (int e = 0; e < 4; ++e) {
            const int row = i * 16 + q * 4 + e, t = tb + 4 * j;
            uu[j][e] = Ug[(long)row * 512 + t * 16 + r];
          }
#pragma unroll
        for (int j = 0; j < 4; ++j)
#pragma unroll
          for (int e = 0; e < 4; ++e) {
            const int row = i * 16 + q * 4 + e, t = tb + 4 * j;
            if (row < nrows) {
              float y = acc[i][j][e] + dd * bf2f(uu[j][e]);
              long token = samp ? (long)NP + row * 32 + t : (long)b * 2048 + row * 32 + t;
              yg[token * 512 + g * 16 + r] = f2bf(gelu_f(y));
            }
          }
      }
    }
  }
  __syncthreads();
}


__device__ __forceinline__ void l2_scrub(const Params& p, unsigned char* ws, int seam) {
  const uint4* xs = (const uint4*)p.in[0] + (long)(blockIdx.x & 511) * 16384 + (seam & 1) * 8192;
  unsigned acc = 0;
#pragma unroll 8
  for (int i = threadIdx.x; i < 8192; i += 256) { uint4 v = xs[i]; acc ^= v.x ^ v.y ^ v.z ^ v.w; }
  if (acc == 0x9e3779b9u + (unsigned)seam && ws == nullptr) ((volatile unsigned*)ws)[0] = acc;
}
#define XB_TMO      128
#define XB_XCNT(j)  (256  + 64 * (j))
#define XB_XSUB(j)  (1280 + 64 * (j))
#define XB_XGEN(j)  (2304 + 64 * (j))
#define XB_TOP      3328
#define XB_TOPGEN   3392
#define XCD_BAR_WORDS 3456
#define XB_SPIN_CAP (1u << 18)
#define LAS __attribute__((address_space(3)))

__device__ __forceinline__ unsigned xb_ld(unsigned* p)              { return __hip_atomic_load(p, __ATOMIC_RELAXED, __HIP_MEMORY_SCOPE_AGENT); }
__device__ __forceinline__ unsigned xb_add(unsigned* p, unsigned v) { return __hip_atomic_fetch_add(p, v, __ATOMIC_RELAXED, __HIP_MEMORY_SCOPE_AGENT); }
__device__ __forceinline__ unsigned xb_xcc_id() { return (unsigned)__builtin_amdgcn_s_getreg((3 << 11) | 20) & 0xFu; }
#define XB_SPIN(cond, bar) do { unsigned _sp = 0; while (cond) { __builtin_amdgcn_s_sleep(1); \
    if ((++_sp & 255u) == 0u) { if (xb_ld(&(bar)[XB_TMO])) break; if (_sp > XB_SPIN_CAP) { atomicAdd(&(bar)[XB_TMO], 1u); break; } } } } while (0)

struct XcdBarrier {
    unsigned* bar; unsigned x;
    volatile LAS unsigned* st;
};

__device__ __forceinline__ XcdBarrier xcd_barrier_post(unsigned* bar, volatile LAS unsigned* st) {
    XcdBarrier b; b.bar = bar; b.x = xb_xcc_id(); b.st = st;
    if (threadIdx.x == 0) (void)xb_add(&bar[XB_XCNT(b.x)], 1u);
    return b;
}
__device__ __forceinline__ void xcd_barrier_complete(unsigned* bar, unsigned x, unsigned& nloc, unsigned& nx) {
    const unsigned G = gridDim.x * gridDim.y * gridDim.z;
    unsigned sum, cnt, mine, sp = 0u;
    for (;;) {
        sum = 0u; cnt = 0u; mine = 0u;
#pragma unroll
        for (unsigned j = 0; j < 16; ++j) { const unsigned c = xb_ld(&bar[XB_XCNT(j)]); sum += c; cnt += (c > 0u) ? 1u : 0u; mine = (j == x) ? c : mine; }
        if (sum == G) break;
        __builtin_amdgcn_s_sleep(1);
        if ((++sp & 255u) == 0u) { if (xb_ld(&bar[XB_TMO])) break; if (sp > XB_SPIN_CAP) { atomicAdd(&bar[XB_TMO], 1u); break; } }
    }
    nloc = mine > 0u ? mine : 1u; nx = cnt > 0u ? cnt : 1u;
}

__device__ __forceinline__ void xcd_barrier(const XcdBarrier& b) {
    asm volatile("s_waitcnt vmcnt(0)" ::: "memory");
    __syncthreads();
    if (threadIdx.x == 0) {
        unsigned* bar = b.bar;
        __builtin_amdgcn_s_waitcnt(0);
        unsigned nloc = b.st[0], nx = b.st[1];
        if (nloc == 0u) { xcd_barrier_complete(bar, b.x, nloc, nx); b.st[0] = nloc; b.st[1] = nx; }
        const unsigned old = xb_add(&bar[XB_XSUB(b.x)], 1u);
        const unsigned gen = old / nloc;
        if (old + 1u == (gen + 1u) * nloc) {
            __builtin_amdgcn_fence(__ATOMIC_RELEASE, "agent");
            asm volatile("s_waitcnt vmcnt(0)" ::: "memory");
            const unsigned og = xb_add(&bar[XB_TOP], 1u);
            const unsigned tg = og / nx;
            if (og + 1u == (tg + 1u) * nx) xb_add(&bar[XB_TOPGEN], 1u);
            else XB_SPIN(xb_ld(&bar[XB_TOPGEN]) == tg, bar);
            __builtin_amdgcn_fence(__ATOMIC_ACQUIRE, "agent");
            xb_add(&bar[XB_XGEN(b.x)], 1u);
            asm volatile("s_waitcnt vmcnt(0)" ::: "memory");
        } else {
            XB_SPIN(xb_ld(&bar[XB_XGEN(b.x)]) == gen, bar);
            __builtin_amdgcn_fence(__ATOMIC_ACQUIRE, "agent");
            asm volatile("s_waitcnt vmcnt(0)" ::: "memory");
        }
    }
    __syncthreads();
}


#define GRID_SYNC() do { \
    xcd_barrier(xbar); \
    ++sync_no; \
    l2_scrub(p, ws, sync_no); \
  } while (0)
#ifndef REP_P0
#define REP_P0 1
#endif
#ifndef REP_P1
#define REP_P1 1
#endif
#ifndef REP_P2
#define REP_P2 1
#endif
#ifndef REP_P3
#define REP_P3 1
#endif
#ifndef REP_P4
#define REP_P4 1
#endif
#ifndef REP_P5
#define REP_P5 1
#endif
__global__ void __launch_bounds__(256, 2) mega(Params p) {
  extern __shared__ __attribute__((aligned(16))) unsigned char smem[];
  cg::grid_group grid = cg::this_grid();
  unsigned char* ws = p.ws;
  const int G = gridDim.x, bid = blockIdx.x;
  int sync_no = 0;
  if (ws == nullptr) grid.sync();
  volatile LAS unsigned* xb_st = (volatile LAS unsigned*)(smem + 74752);
  if (threadIdx.x == 0) { xb_st[0] = 0u; xb_st[1] = 0u; xb_st[2] = 0u; xb_st[3] = 0u; }
  __syncthreads();
  const XcdBarrier xbar = xcd_barrier_post((unsigned*)(ws + OFF_BAR), xb_st);

#pragma unroll 1
  for (int rep = 0; rep < REP_P0; ++rep) {
    phase0(p, smem);
    GRID_SYNC();
  }

#pragma unroll 1
  for (int rep = 0; rep < REP_P1; ++rep) {
    GemmOp g;
    g.A = (const bfu*)(ws + OFF_XB); g.A_hi = g.A; g.lda = 1024; g.ksplit = 1 << 30;
    g.Bt = (const bfu*)(ws + OFF_WIN); g.ldb = 1024; g.K = 1024;
    for (int l = bid >> 3; l < 33 * 16; l += (G >> 3)) {
      const int m0 = ((bid & 7) + 8 * (l >> 4)) * 128, n0 = (l & 15) * 128;
      gemm_tile<false>(g, m0, n0, smem, nullptr);
      epi_win(p, m0, n0, (const float*)smem);
      __syncthreads();
    }
    GRID_SYNC();
  }

  #pragma unroll 1
  for (int rep = 0; rep < REP_P2; ++rep) {
    GemmOp gq;
    gq.A = (const bfu*)(ws + OFF_CQ); gq.A_hi = gq.A; gq.lda = 256; gq.ksplit = 1 << 30;
    gq.Bt = (const bfu*)(ws + OFF_WUQ); gq.ldb = 256; gq.K = 256;
    GemmOp gk;
    gk.A = (const bfu*)(ws + OFF_CKVB); gk.A_hi = gk.A; gk.lda = 128; gk.ksplit = 1 << 30;
    gk.Bt = (const bfu*)(ws + OFF_WUKV); gk.ldb = 128; gk.K = 128;
    const int nq = 33 * 6, nkv = 65 * 8;
    for (int l = bid >> 3; l < nq + nkv; l += (G >> 3)) {
      if (l < nq) {
        const int m0 = ((bid & 7) + 8 * (l / 6)) * 128, n0 = (l % 6) * 128;
        gemm_tile<false>(gq, m0, n0, smem, nullptr);
        epi_q(p, m0, n0, (const float*)smem);
      } else {
        const int k = l - nq;
        const int m0 = ((bid & 7) + 8 * (k >> 3)) * 128, n0 = (k & 7) * 128;
        gemm_tile<false>(gk, m0, n0, smem, nullptr);
        epi_kv(p, m0, n0, (const float*)smem);
      }
      __syncthreads();
    }
    GRID_SYNC();
  }

  #pragma unroll 1
  for (int rep = 0; rep < REP_P3; ++rep) {
    for (int it = bid; it < 256; it += G) attn_sample_item(p, it, smem);
    for (int k = G - 1 - bid; k < 576; k += G) {
      if (k < 512) ssm_item(p, k & 31, k >> 5, false, smem, 0, 2);
      else ssm_item(p, (k - 512) >> 1, 0, true, smem, (k - 512) & 1, ((k - 512) & 1) + 1);
    }
    const int rounds = (2048 + G - 1) / G;
    for (int rd = 0; rd < rounds; ++rd) {
      const int pos = (rd & 1) ? (G - 1 - bid) : bid;
      const int it = rd * G + pos;
      if (it < 2048) attn_prompt_item(p, it & 127, 15 - (it >> 7), smem);
    }
    GRID_SYNC();
  }

  #pragma unroll 1
  for (int rep = 0; rep < REP_P4; ++rep) {
    GemmOp g;
    g.A = (const bfu*)(ws + OFF_YG); g.A_hi = g.A; g.lda = 512; g.ksplit = 1 << 30;
    g.Bt = (const bfu*)(ws + OFF_WGLU); g.ldb = 512; g.K = 512;
    for (int l = bid >> 3; l < 33 * 4; l += (G >> 3)) {
      const int m0 = ((bid & 7) + 8 * (l >> 2)) * 128, n0 = (l & 3) * 128;
      gemm_tile<false>(g, m0, n0, smem, nullptr);
      epi_glu(p, m0, n0, (const float*)smem);
      __syncthreads();
    }
    GRID_SYNC();
  }

  #pragma unroll 1
  for (int rep = 0; rep < REP_P5; ++rep) {
    GemmOp g;
    g.A = (const bfu*)(ws + OFF_A1); g.A_hi = (const bfu*)(ws + OFF_A2); g.lda = 512; g.ksplit = 512;
    g.Bt = (const bfu*)(ws + OFF_WOUT); g.ldb = 1024; g.K = 1024;
    float* sRatio = (float*)(smem + 73728);
    float* sR2 = sRatio + 128;
    const float* ssq1 = (const float*)(ws + OFF_SSQ1);
    const float* ssq2 = (const float*)(ws + OFF_SSQ2);
    for (int l = bid >> 3; l < 33 * 8; l += (G >> 3)) {
      const int m0 = ((bid & 7) + 8 * (l >> 3)) * 128, n0 = (l & 7) * 128;
      if (threadIdx.x < 128) {
        const long row = m0 + threadIdx.x;
        float s1 = ssq1[row] + ssq1[NTOK + row] + ssq1[2L * NTOK + row] + ssq1[3L * NTOK + row];
        float s2 = 0.f;
#pragma unroll
        for (int i = 0; i < 8; ++i) s2 += ssq2[(long)i * NTOK + row];
        float r1 = rsqrtf(s1 * (1.f / 512.f) + EPS), r2 = rsqrtf(s2 * (1.f / 512.f) + EPS);
        sRatio[threadIdx.x] = r1 / r2;
        sR2[threadIdx.x] = r2;
      }
      gemm_tile<true>(g, m0, n0, smem, sRatio);
      epi_out(p, m0, n0, (const float*)smem, sR2);
      __syncthreads();
    }
  }
}

extern "C" void kernel_launch(void* const* d_in, const int* in_sizes, int n_in, void* d_out, int out_size,
                              void* d_ws, size_t ws_size, hipStream_t stream) {
  static int grid_blocks = 0;
  if (!grid_blocks) {
    int dev = 0, cus = 0, per_cu = 0;
    hipGetDevice(&dev);
    hipDeviceGetAttribute(&cus, hipDeviceAttributeMultiprocessorCount, dev);
    hipFuncSetAttribute((const void*)mega, hipFuncAttributeMaxDynamicSharedMemorySize, LDS_BYTES);
    hipOccupancyMaxActiveBlocksPerMultiprocessor(&per_cu, (const void*)mega, 256, LDS_BYTES);
    if (per_cu > 2) per_cu = 2;
    if (per_cu < 1) per_cu = 1;
    grid_blocks = cus * per_cu;
    if (ws_size < WS_END) fprintf(stderr, "kernel_launch: workspace too small: %zu < %zu\n", ws_size, (size_t)WS_END);
  }
  if (ws_size < WS_END) return;
  Params p{};
  for (int i = 0; i < 29; ++i) p.in[i] = (const float*)d_in[i];
  p.out = (float*)d_out;
  p.ws = (unsigned char*)d_ws;
  hipMemsetAsync((unsigned char*)d_ws + OFF_BAR, 0, BAR_BYTES, stream);
  void* args[] = {&p};
  hipError_t e = hipLaunchCooperativeKernel((const void*)mega, dim3(grid_blocks), dim3(256), args, LDS_BYTES, stream);
  if (e != hipSuccess) fprintf(stderr, "cooperative launch failed: %s (grid %d)\n", hipGetErrorString(e), grid_blocks);
}
```
